# Optimizing an MI355X kernel written in HIP

```python
import math
import jax
import jax.numpy as jnp
from jax import lax
import numpy as np

D_MODEL = 1024
BATCH = 4
SEQ = 8192
DEPTH = 4

GRID_W = 64
CTX_LEN = 256
N_EVEN = (DEPTH + 1) // 2
N_ODD = DEPTH // 2
EPS = 1e-6
F32 = jnp.float32

A_HEADS = 4
A_DK = 128
A_DV = 128
A_CONV = 4
A_CHUNK = 64
A_QKV = 2 * A_HEADS * A_DK + A_HEADS * A_DV
B_HEADS = 4
B_DK = 128
B_DV = 128
B_CHUNK = 64
C_HEADS = 8
C_KV_HEADS = 2
C_HD = 64
C_WIN = 128
C_BLOCK = 128
ROPE_THETA = 10000.0
D_WIDTH = 512
D_BLOCKS = 8
D_BW = D_WIDTH // D_BLOCKS
D_CONV = 4
D_C = 8.0
N_EXPERTS = 16
EXPERT_FF = 1024
EC_FACTOR = 2

EVEN_SIZES = (A_QKV, A_HEADS * A_DV, 2 * A_HEADS, 2 * A_HEADS,
              B_HEADS * B_DK, B_HEADS * B_DV, 2 * B_HEADS * B_DK, B_HEADS * B_DV)
EVEN_OUT = A_HEADS * A_DV + B_HEADS * B_DV
ODD_SIZES = (C_HEADS * C_HD, C_KV_HEADS * C_HD, C_KV_HEADS * C_HD, D_WIDTH, D_WIDTH)
ODD_OUT = C_HEADS * C_HD + D_WIDTH

kernel_name = "hybrid_deltanet_hgrn2_swa_rglru_ec_moe_dit"


def _cuts(sizes):
    out, acc = [], 0
    for s in sizes[:-1]:
        acc += s
        out.append(acc)
    return out


def rmsnorm(x, w):
    xf = x.astype(F32)
    y = xf * lax.rsqrt(jnp.mean(xf * xf, axis=-1, keepdims=True) + EPS)
    return (y * w).astype(x.dtype)


def _modulate(h, shift, scale):
    return h * (1 + scale) + shift


def _l2norm(t):
    return t * lax.rsqrt(jnp.sum(t * t, axis=-1, keepdims=True) + EPS)


def _flip(t):
    return jnp.flip(t, axis=1)


def dwconv(x, w):
    k = w.shape[0]
    return lax.conv_general_dilated(x, w[:, None, :].astype(x.dtype), (1,), [((k - 1) // 2, k // 2)],
                                    dimension_numbers=('NWC', 'WIO', 'NWC'),
                                    feature_group_count=x.shape[-1])


def _to_chunks(t, length):
    b_, n, h = t.shape[:3]
    rest = t.shape[3:]
    t = t.reshape((b_, n // length, length, h) + rest)
    return t.transpose((1, 0, 3, 2) + tuple(range(4, t.ndim)))


def _from_chunks(t):
    nc, b_, h, length, d = t.shape
    return t.transpose(1, 0, 3, 2, 4).reshape(b_, nc * length, h, d)


def gated_delta_chunked(q, k, v, g, beta, s0):
    length = A_CHUNK
    dv = v.shape[-1]
    q, k, v = _to_chunks(q, length), _to_chunks(k, length), _to_chunks(v, length)
    g, beta = _to_chunks(g, length), _to_chunks(beta, length)
    cum = jnp.cumsum(g, axis=-1)
    incl = jnp.tril(jnp.ones((length, length), bool))
    strict = jnp.tril(jnp.ones((length, length), bool), -1)
    decay = jnp.exp(jnp.where(incl, cum[..., :, None] - cum[..., None, :], -jnp.inf))
    kb = k * beta[..., None]
    m = jnp.where(strict, jnp.einsum('...id,...jd->...ij', kb, k) * decay, 0.0)
    rhs = jnp.concatenate([v * beta[..., None], kb * jnp.exp(cum)[..., None]], axis=-1)
    sol = lax.linalg.triangular_solve(m + jnp.eye(length, dtype=m.dtype), rhs, left_side=True, lower=True)
    u, w = sol[..., :dv], sol[..., dv:]
    qk = jnp.einsum('...id,...jd->...ij', q, k) * decay
    q_dec = q * jnp.exp(cum)[..., None]
    k_dec = k * jnp.exp(cum[..., -1:] - cum)[..., None]
    g_last = jnp.exp(cum[..., -1])

    def step(s, inp):
        u_c, w_c, qk_c, qd_c, kd_c, gl_c = inp
        v_new = u_c - jnp.einsum('bhld,bhdv->bhlv', w_c, s)
        o = jnp.einsum('bhld,bhdv->bhlv', qd_c, s) + jnp.einsum('bhlm,bhmv->bhlv', qk_c, v_new)
        s = s * gl_c[..., None, None] + jnp.einsum('bhld,bhlv->bhdv', kd_c, v_new)
        return s, o

    s_fin, o = lax.scan(step, s0, (u, w, qk, q_dec, k_dec, g_last))
    return _from_chunks(o), s_fin


def hgrn2_chunked(q, k, v, lf, s0):
    length = B_CHUNK
    q, k, v, lf = (_to_chunks(t, length) for t in (q, k, v, lf))
    cum = jnp.cumsum(lf, axis=-2)
    incl = jnp.tril(jnp.ones((length, length), bool))[:, :, None]

    def step(s, inp):
        q_c, k_c, v_c, b_c = inp
        dec = jnp.exp(jnp.where(incl, b_c[..., :, None, :] - b_c[..., None, :, :], -jnp.inf))
        att = jnp.einsum('bhid,bhjd,bhijd->bhij', q_c, k_c, dec)
        b_last = b_c[..., -1:, :]
        o = jnp.einsum('bhij,bhjv->bhiv', att, v_c) + jnp.einsum('bhid,bhdv->bhiv', q_c * jnp.exp(b_c), s)
        s = s * jnp.exp(b_last)[..., 0, :, None] + jnp.einsum('bhjd,bhjv->bhdv', k_c * jnp.exp(b_last - b_c), v_c)
        return s, o

    s_fin, o = lax.scan(step, s0, (q, k, v, cum))
    return _from_chunks(o), s_fin


def delta_group(qkv, gate, alpha, beta, conv_w, a_log, dt_bias, norm_w, s0):
    b_, n, _ = qkv.shape
    qkv = jax.nn.silu(dwconv(qkv, conv_w)).astype(F32)
    q, k, v = jnp.split(qkv, [A_HEADS * A_DK, 2 * A_HEADS * A_DK], axis=-1)
    q = _l2norm(q.reshape(b_, n, A_HEADS, A_DK)) * (A_DK ** -0.5)
    k = _l2norm(k.reshape(b_, n, A_HEADS, A_DK))
    v = v.reshape(b_, n, A_HEADS, A_DV)
    g = -jnp.exp(a_log) * jax.nn.softplus(alpha.astype(F32).reshape(b_, n, 2, A_HEADS) + dt_bias)
    bt = jax.nn.sigmoid(beta.astype(F32).reshape(b_, n, 2, A_HEADS))
    o_f, s_f = gated_delta_chunked(q, k, v, g[:, :, 0], bt[:, :, 0], s0[0])
    o_b, s_b = gated_delta_chunked(_flip(q), _flip(k), _flip(v), _flip(g[:, :, 1]), _flip(bt[:, :, 1]), s0[1])
    o = o_f + _flip(o_b)
    o = rmsnorm(o, norm_w) * jax.nn.silu(gate.astype(F32).reshape(b_, n, A_HEADS, A_DV))
    return o.reshape(b_, n, A_HEADS * A_DV), (s_f, s_b)


def hgrn2_group(q, i, f, gate, lb, norm_w, s0):
    b_, n, _ = q.shape
    q = jax.nn.silu(q.astype(F32)).reshape(b_, n, B_HEADS, B_DK)
    v = i.astype(F32).reshape(b_, n, B_HEADS, B_DV)
    fg = lb + (1.0 - lb) * jax.nn.sigmoid(f.astype(F32).reshape(b_, n, 2, B_HEADS, B_DK))
    lf = jnp.log(fg)
    k = 1.0 - fg
    o_f, s_f = hgrn2_chunked(q, k[:, :, 0], v, lf[:, :, 0], s0[0])
    o_b, s_b = hgrn2_chunked(_flip(q), _flip(k[:, :, 1]), _flip(v), _flip(lf[:, :, 1]), s0[1])
    o = o_f + _flip(o_b)
    o = rmsnorm(o, norm_w) * jax.nn.silu(gate.astype(F32).reshape(b_, n, B_HEADS, B_DV))
    return o.reshape(b_, n, B_HEADS * B_DV), (s_f, s_b)


def even_mixer(h_c, h_l, w_in, w_out, conv_w, a_log, dt_bias, a_norm_w, lb, b_norm_w, ctx_out):
    b_ = h_l.shape[0]
    zero_a = jnp.zeros((b_, A_HEADS, A_DK, A_DV), F32)
    zero_b = jnp.zeros((b_, B_HEADS, B_DK, B_DV), F32)

    def run(h, st_a, st_b):
        qkv, ga, al, be, qb, ib, fb, gb = jnp.split(h @ w_in, _cuts(EVEN_SIZES), axis=-1)
        oa, st_a = delta_group(qkv, ga, al, be, conv_w, a_log, dt_bias, a_norm_w, st_a)
        ob, st_b = hgrn2_group(qb, ib, fb, gb, lb, b_norm_w, st_b)
        return jnp.concatenate([oa, ob], axis=-1).astype(h.dtype), st_a, st_b

    o_c, st_a, st_b = run(h_c, (zero_a, zero_a), (zero_b, zero_b))
    o_l, _, _ = run(h_l, st_a, st_b)
    y_c = o_c @ w_out if ctx_out else None
    return y_c, o_l @ w_out


def rope_2d(t, row, col):
    half = t.shape[-1] // 2
    nf = half // 2
    inv = ROPE_THETA ** (-jnp.arange(nf, dtype=F32) / nf)

    def rot(u, pos):
        ang = pos.astype(F32)[:, None] * inv
        cos, sin = jnp.cos(ang)[None, :, None, :], jnp.sin(ang)[None, :, None, :]
        u1, u2 = u[..., :nf], u[..., nf:]
        return jnp.concatenate([u1 * cos - u2 * sin, u2 * cos + u1 * sin], axis=-1)

    return jnp.concatenate([rot(t[..., :half], row), rot(t[..., half:], col)], axis=-1)


def _sink_softmax(s, sink):
    m = jnp.maximum(jnp.max(s, axis=-1, keepdims=True), sink)
    e = jnp.exp(s - m)
    return e / (jnp.sum(e, axis=-1, keepdims=True) + jnp.exp(sink - m))


def window_attention(q_l, k_l, v_l, k_c, v_c, sink):
    b_, n, h, hd = q_l.shape
    grp = h // C_KV_HEADS
    nb = n // C_BLOCK
    qb = q_l.reshape(b_, nb, C_BLOCK, C_KV_HEADS, grp, hd) * (hd ** -0.5)

    def band(t):
        tp = jnp.pad(t, ((0, 0), (C_BLOCK, C_BLOCK), (0, 0), (0, 0))).reshape(b_, nb + 2, C_BLOCK, C_KV_HEADS, hd)
        return jnp.concatenate([tp[:, :-2], tp[:, 1:-1], tp[:, 2:]], axis=2)

    kb, vb = band(k_l), band(v_l)
    s_lat = jnp.einsum('bnqkgd,bnskd->bnkgqs', qb, kb)
    s_ctx = jnp.einsum('bnqkgd,bskd->bnkgqs', qb, k_c)
    qpos = jnp.arange(C_BLOCK)[:, None]
    kpos = jnp.arange(3 * C_BLOCK)[None, :] - C_BLOCK
    s_abs = jnp.arange(nb)[:, None, None] * C_BLOCK + kpos[None]
    mask = (jnp.abs(kpos - qpos) <= C_WIN)[None] & (s_abs >= 0) & (s_abs < n)
    s_lat = jnp.where(mask[None, :, None, None], s_lat, -jnp.inf)
    sink_b = sink.astype(F32).reshape(C_KV_HEADS, grp)[None, None, :, :, None, None]
    p = _sink_softmax(jnp.concatenate([s_lat, s_ctx], axis=-1), sink_b)
    o = (jnp.einsum('bnkgqs,bnskd->bnqkgd', p[..., :3 * C_BLOCK], vb)
         + jnp.einsum('bnkgqs,bskd->bnqkgd', p[..., 3 * C_BLOCK:], v_c))
    return o.reshape(b_, n, h * hd)


def context_attention(q_c, k_c, v_c, sink):
    b_, lc, h, hd = q_c.shape
    grp = h // C_KV_HEADS
    qg = q_c.reshape(b_, lc, C_KV_HEADS, grp, hd) * (hd ** -0.5)
    s = jnp.einsum('bqkgd,bskd->bkgqs', qg, k_c)
    p = _sink_softmax(s, sink.astype(F32).reshape(C_KV_HEADS, grp)[None, :, :, None, None])
    return jnp.einsum('bkgqs,bskd->bqkgd', p, v_c).reshape(b_, lc, h * hd)


def _linear_scan(a, u, h0):
    u = u.at[:, 0].add(a[:, 0] * h0)
    _, h = lax.associative_scan(lambda l, r: (l[0] * r[0], r[0] * l[1] + r[1]), (a, u), axis=1)
    return h, h[:, -1]


def rglru_group(xb, gb, conv_w, conv_b, w_r, b_r, w_i, b_i, lam, s0):
    b_, n, _ = xb.shape
    xc = (dwconv(xb, conv_w) + conv_b).astype(F32)
    xblk = xc.reshape(b_, n, D_BLOCKS, D_BW)
    r = jax.nn.sigmoid(jnp.einsum('bnhi,zhij->bnzhj', xblk, w_r.astype(F32)).reshape(b_, n, 2, D_WIDTH) + b_r)
    gi = jax.nn.sigmoid(jnp.einsum('bnhi,zhij->bnzhj', xblk, w_i.astype(F32)).reshape(b_, n, 2, D_WIDTH) + b_i)
    log_a = -D_C * jax.nn.softplus(-lam) * r
    a = jnp.exp(log_a)
    u = jnp.sqrt(-jnp.expm1(2.0 * log_a)) * gi * xc[:, :, None, :]
    h_f, s_f = _linear_scan(a[:, :, 0], u[:, :, 0], s0[0])
    h_b, s_b = _linear_scan(_flip(a[:, :, 1]), _flip(u[:, :, 1]), s0[1])
    y = (h_f + _flip(h_b)) * jax.nn.gelu(gb.astype(F32))
    return y, (s_f, s_b)


def odd_mixer(h_c, h_l, w_in, w_out, sink, d_conv_w, d_conv_b, d_w_r, d_b_r, d_w_i, d_b_i, d_lambda,
              row, col, ctx_out):
    b_ = h_l.shape[0]
    qc, kc, vc, xdc, gdc = jnp.split(h_c @ w_in, _cuts(ODD_SIZES), axis=-1)
    ql, kl, vl, xdl, gdl = jnp.split(h_l @ w_in, _cuts(ODD_SIZES), axis=-1)

    def heads(t, nh):
        return t.astype(F32).reshape(t.shape[0], t.shape[1], nh, C_HD)

    kc, vc = heads(kc, C_KV_HEADS), heads(vc, C_KV_HEADS)
    att_l = window_attention(rope_2d(heads(ql, C_HEADS), row, col), rope_2d(heads(kl, C_KV_HEADS), row, col),
                             heads(vl, C_KV_HEADS), kc, vc, sink)
    zero = jnp.zeros((b_, D_WIDTH), F32)
    rg_c, st = rglru_group(xdc, gdc, d_conv_w, d_conv_b, d_w_r, d_b_r, d_w_i, d_b_i, d_lambda, (zero, zero))
    rg_l, _ = rglru_group(xdl, gdl, d_conv_w, d_conv_b, d_w_r, d_b_r, d_w_i, d_b_i, d_lambda, st)
    y_l = jnp.concatenate([att_l, rg_l], axis=-1).astype(h_l.dtype) @ w_out
    y_c = None
    if ctx_out:
        att_c = context_attention(heads(qc, C_HEADS), kc, vc, sink)
        y_c = jnp.concatenate([att_c, rg_c], axis=-1).astype(h_c.dtype) @ w_out
    return y_c, y_l


def expert_choice_ffn(h, router, w1, w3, w2):
    b_, n, d = h.shape
    cap = max(1, EC_FACTOR * n // N_EXPERTS)
    aff = jax.nn.softmax(jnp.einsum('bnd,de->bne', h, router).astype(F32), axis=-1)
    gate, idx = lax.top_k(jnp.swapaxes(aff, 1, 2), cap)
    xs = jax.vmap(lambda hb, ib: hb[ib])(h, idx)
    hid = jax.nn.silu(jnp.einsum('becd,edf->becf', xs, w1)) * jnp.einsum('becd,edf->becf', xs, w3)
    out = jnp.einsum('becf,efd->becd', hid, w2) * gate[..., None].astype(h.dtype)
    return jax.vmap(lambda ob, ib: jnp.zeros((n, d), ob.dtype).at[ib.reshape(-1)].add(ob.reshape(-1, d)))(out, idx)


def setup_inputs(seed: int = 0) -> dict:
    key = jax.random.key(seed)
    ks = iter(jax.random.split(key, 32))

    def nrm(shape, scale):
        return jax.random.normal(next(ks), shape, F32) * scale

    def unif(shape, lo, hi):
        return jax.random.uniform(next(ks), shape, F32, lo, hi)

    dt = jnp.exp(unif((N_EVEN, 2, A_HEADS), math.log(1e-3), math.log(1e-1)))
    a_pow = unif((N_ODD, 2, D_WIDTH), 0.9, 0.999) ** (1.0 / D_C)
    return {
        'x': nrm((BATCH, SEQ, D_MODEL), 1.0),
        'c': nrm((BATCH, D_MODEL), 1.0),
        'ctx': nrm((BATCH, CTX_LEN, D_MODEL), 1.0),
        'c_ctx': nrm((D_MODEL,), 1.0),
        'w_mod': nrm((DEPTH, D_MODEL, 6 * D_MODEL), 0.5 * D_MODEL ** -0.5),
        'b_mod': nrm((DEPTH, 6 * D_MODEL), 0.02),
        'norm1_w': 1.0 + nrm((DEPTH, D_MODEL), 0.02),
        'norm2_w': 1.0 + nrm((DEPTH, D_MODEL), 0.02),
        'final_norm_w': 1.0 + nrm((D_MODEL,), 0.02),
        'ev_w_in': nrm((N_EVEN, D_MODEL, sum(EVEN_SIZES)), D_MODEL ** -0.5),
        'ev_w_out': nrm((N_EVEN, EVEN_OUT, D_MODEL), EVEN_OUT ** -0.5),
        'a_conv_w': nrm((N_EVEN, A_CONV, A_QKV), A_CONV ** -0.5),
        'a_log': jnp.log(unif((N_EVEN, 2, A_HEADS), 1.0, 16.0)),
        'a_dt_bias': dt + jnp.log(-jnp.expm1(-dt)),
        'a_norm_w': 1.0 + nrm((N_EVEN, A_DV), 0.02),
        'b_lb_logits': nrm((N_EVEN, 2, B_HEADS, B_DK), 1.0),
        'b_norm_w': 1.0 + nrm((N_EVEN, B_DV), 0.02),
        'od_w_in': nrm((N_ODD, D_MODEL, sum(ODD_SIZES)), D_MODEL ** -0.5),
        'od_w_out': nrm((N_ODD, ODD_OUT, D_MODEL), ODD_OUT ** -0.5),
        'c_sink': nrm((N_ODD, C_HEADS), 0.5),
        'd_conv_w': nrm((N_ODD, D_CONV, D_WIDTH), D_CONV ** -0.5),
        'd_conv_b': nrm((N_ODD, D_WIDTH), 0.01),
        'd_w_r': nrm((N_ODD, 2, D_BLOCKS, D_BW, D_BW), D_BW ** -0.5),
        'd_b_r': nrm((N_ODD, 2, D_WIDTH), 0.01),
        'd_w_i': nrm((N_ODD, 2, D_BLOCKS, D_BW, D_BW), D_BW ** -0.5),
        'd_b_i': nrm((N_ODD, 2, D_WIDTH), 0.01),
        'd_lambda': jnp.log(a_pow) - jnp.log1p(-a_pow),
        'moe_router': nrm((DEPTH, D_MODEL, N_EXPERTS), D_MODEL ** -0.5),
        'moe_w1': nrm((DEPTH, N_EXPERTS, D_MODEL, EXPERT_FF), D_MODEL ** -0.5),
        'moe_w3': nrm((DEPTH, N_EXPERTS, D_MODEL, EXPERT_FF), D_MODEL ** -0.5),
        'moe_w2': nrm((DEPTH, N_EXPERTS, EXPERT_FF, D_MODEL), EXPERT_FF ** -0.5),
    }


def reference(x, c, ctx, c_ctx, w_mod, b_mod, norm1_w, norm2_w, final_norm_w,
              ev_w_in, ev_w_out, a_conv_w, a_log, a_dt_bias, a_norm_w, b_lb_logits, b_norm_w,
              od_w_in, od_w_out, c_sink, d_conv_w, d_conv_b, d_w_r, d_b_r, d_w_i, d_b_i, d_lambda,
              moe_router, moe_w1, moe_w3, moe_w2):
    n = x.shape[1]
    rows = n // GRID_W
    row = jnp.repeat(jnp.arange(rows, dtype=jnp.int32), GRID_W)
    col = jnp.tile(jnp.arange(GRID_W, dtype=jnp.int32), rows)
    lb_all = jnp.cumsum(jax.nn.softmax(b_lb_logits.astype(F32), axis=0), axis=0)
    lb_all = lb_all - lb_all[0:1]
    for l in range(DEPTH):
        last = l == DEPTH - 1
        j = l // 2
        mod = (jax.nn.silu(c) @ w_mod[l] + b_mod[l])[:, None, :]
        mod_c = jax.nn.silu(c_ctx) @ w_mod[l] + b_mod[l]
        sh1, sc1, g1, sh2, sc2, g2 = jnp.split(mod, 6, axis=-1)
        csh1, csc1, cg1, csh2, csc2, cg2 = jnp.split(mod_c, 6, axis=-1)
        h_l = _modulate(rmsnorm(x, norm1_w[l]), sh1, sc1)
        h_c = _modulate(rmsnorm(ctx, norm1_w[l]), csh1, csc1)
        if l % 2 == 0:
            y_c, y_l = even_mixer(h_c, h_l, ev_w_in[j], ev_w_out[j], a_conv_w[j], a_log[j], a_dt_bias[j],
                                  a_norm_w[j], lb_all[j], b_norm_w[j], not last)
        else:
            y_c, y_l = odd_mixer(h_c, h_l, od_w_in[j], od_w_out[j], c_sink[j], d_conv_w[j], d_conv_b[j],
                                 d_w_r[j], d_b_r[j], d_w_i[j], d_b_i[j], d_lambda[j], row, col, not last)
        x = x + g1 * y_l
        h_l = _modulate(rmsnorm(x, norm2_w[l]), sh2, sc2)
        x = x + g2 * expert_choice_ffn(h_l, moe_router[l], moe_w1[l], moe_w3[l], moe_w2[l])
        if not last:
            ctx = ctx + cg1 * y_c
            h_c = _modulate(rmsnorm(ctx, norm2_w[l]), csh2, csc2)
            ctx = ctx + cg2 * expert_choice_ffn(h_c, moe_router[l], moe_w1[l], moe_w3[l], moe_w2[l])
    return rmsnorm(x, final_norm_w)
```

```cpp
#include <hip/hip_runtime.h>
#include <cstdio>
#include <cstdint>

#define REPK -1
#define REPS -1
#ifndef MK_ONE_LAUNCH
#define MK_ONE_LAUNCH 1
#endif

namespace pg8 {
#define PG8_LAS __attribute__((address_space(3)))
typedef unsigned short bf16_t;
typedef short bf16x8 __attribute__((ext_vector_type(8)));
typedef float f32x4 __attribute__((ext_vector_type(4)));
typedef unsigned u32x4 __attribute__((ext_vector_type(4)));
constexpr int BM = 256, BK = 64, HALF = 128, HTB = HALF * BK * 2  , STAGE_BYTES = 8 * HTB, NXCD = 8, WGM = 8;

__host__ __device__ __forceinline__ int lds_byte(int r, int c) { const int st = (r >> 4) * 2 + (c >> 5), rr = r & 15, cc = c & 31, ob = rr * 64 + cc * 2; return st * 1024 + (ob ^ (((ob >> 9) & 1) << 5)); }
__host__ __device__ __forceinline__ void stage_rc(int b, int& R, int& C) { const int st = b / 1024, sb = b % 1024, swz = sb ^ (((sb >> 9) & 1) << 5); R = (st >> 1) * 16 + swz / 64; C = (st & 1) * 32 + (swz % 64) / 2; }
__host__ __device__ __forceinline__ int perm32(int rho) { const int n = rho >> 4, i = rho & 15; return 8 * (i >> 2) + 4 * n + (i & 3); }

struct Unit { int pm, pn; };
struct Gemm { const bf16_t* A; const bf16_t* Bt; int M, N, K; size_t gstride; const int* gidx; int grows; int krep; };
__device__ __forceinline__ size_t bgroup(int pm) { return (size_t)(pm < 256 ? (pm >> 4) : (pm - 256)); }

struct StaticOrder {
    int nM, nN, nwg, G, c;
    __host__ __device__ void init(int M, int N, int G_, int c_) { nM = M / BM; nN = N / BM; nwg = nM * nN; G = G_; c = c_; }
    __host__ __device__ bool next(int i, Unit& u) const {
        const long L = (long)i * G + c; if (L >= nwg) return false;
        int wgid = (int)L; { const int q = nwg / NXCD, r = nwg % NXCD, xcd = wgid % NXCD, off = wgid / NXCD; wgid = (xcd < r ? xcd * (q + 1) : r * (q + 1) + (xcd - r) * q) + off; }
        const int nig = WGM * nN, gid = wgid / nig, fm = gid * WGM, gsz = (nM - fm) < WGM ? (nM - fm) : WGM;
        u.pm = fm + ((wgid % nig) % gsz); u.pn = (wgid % nig) / gsz; return true;
    }
    __device__ __forceinline__ void a_ready(const Unit&) const {}
    __device__ __forceinline__ void done(const Unit&) const {}
};

__device__ __forceinline__ unsigned cvt_pk_bf16(float lo, float hi) { unsigned r; asm volatile("v_cvt_pk_bf16_f32 %0, %1, %2" : "=v"(r) : "v"(lo), "v"(hi)); return r; }

struct EpiStoreBf16 {
    static constexpr bool PERM = true, AFTER_DRAIN = false;
    bf16_t* O; int ldc; const float* rowscale; float mul;
    __device__ __forceinline__ void operator()(const f32x4 (&acc)[2][2][4][2], const Unit& u, int wr, int wc, int fr, int fq) const {
        const int row0 = u.pm * BM + wr * 64 + fr, col0 = u.pn * BM + wc * 32 + 8 * fq;
#pragma unroll
        for (int ai = 0; ai < 2; ++ai)
#pragma unroll
            for (int m = 0; m < 4; ++m) { const int row = row0 + ai * HALF + m * 16; const float sc = (rowscale ? rowscale[row] : 1.f) * (mul != 0.f ? mul : 1.f); bf16_t* rowp = O + (size_t)row * ldc + col0;
#pragma unroll
                for (int bj = 0; bj < 2; ++bj) { const f32x4 v0 = acc[ai][bj][m][0] * sc, v1 = acc[ai][bj][m][1] * sc;
                    u32x4 w; w.x = cvt_pk_bf16(v0[0], v0[1]); w.y = cvt_pk_bf16(v0[2], v0[3]); w.z = cvt_pk_bf16(v1[0], v1[1]); w.w = cvt_pk_bf16(v1[2], v1[3]);
                    *(u32x4*)(rowp + bj * HALF) = w; } }
    }
};

struct EpiResid {
    static constexpr bool PERM = true, AFTER_DRAIN = false;
    const float* xlat; const float* xctx; bf16_t* X; const float* gate;
    __device__ __forceinline__ void operator()(const f32x4 (&acc)[2][2][4][2], const Unit& u, int wr, int wc, int fr, int fq) const {
        const int row0 = u.pm * BM + wr * 64 + fr, col0 = u.pn * BM + wc * 32 + 8 * fq;
        const float* gp = gate + (size_t)(u.pm < 128 ? (u.pm >> 5) : 4) * 6144 + col0;
        f32x4 g[2][2];
#pragma unroll
        for (int bj = 0; bj < 2; ++bj)
#pragma unroll
            for (int n = 0; n < 2; ++n) g[bj][n] = *(const f32x4*)(gp + bj * HALF + 4 * n);
#pragma unroll
        for (int ai = 0; ai < 2; ++ai)
#pragma unroll
            for (int m = 0; m < 4; ++m) { const int row = row0 + ai * HALF + m * 16; bf16_t* xo = X + (size_t)row * 1024 + col0;
#pragma unroll
                for (int bj = 0; bj < 2; ++bj) { f32x4 x0, x1;
                    if (xlat) { const float* xin = (row < 32768 ? xlat + (size_t)row * 1024 : xctx + (size_t)(row - 32768) * 1024) + col0 + bj * HALF; x0 = *(const f32x4*)xin; x1 = *(const f32x4*)(xin + 4); }
                    else { const u32x4 w = *(const u32x4*)(xo + bj * HALF);
                        x0 = (f32x4){__builtin_bit_cast(float, w.x << 16), __builtin_bit_cast(float, w.x & 0xffff0000u), __builtin_bit_cast(float, w.y << 16), __builtin_bit_cast(float, w.y & 0xffff0000u)};
                        x1 = (f32x4){__builtin_bit_cast(float, w.z << 16), __builtin_bit_cast(float, w.z & 0xffff0000u), __builtin_bit_cast(float, w.w << 16), __builtin_bit_cast(float, w.w & 0xffff0000u)}; }
                    const f32x4 o0 = x0 + g[bj][0] * acc[ai][bj][m][0], o1 = x1 + g[bj][1] * acc[ai][bj][m][1];
                    u32x4 ow; ow.x = cvt_pk_bf16(o0[0], o0[1]); ow.y = cvt_pk_bf16(o0[2], o0[3]); ow.z = cvt_pk_bf16(o1[0], o1[1]); ow.w = cvt_pk_bf16(o1[2], o1[3]);
                    *(u32x4*)(xo + bj * HALF) = ow; } }
    }
};

struct EpiSwiGLU {
    static constexpr bool PERM = true, AFTER_DRAIN = false;
    bf16_t* O;
    __device__ __forceinline__ void operator()(const f32x4 (&acc)[2][2][4][2], const Unit& u, int wr, int wc, int fr, int fq) const {
        const int row0 = u.pm * BM + wr * 64 + fr, col0 = u.pn * HALF + wc * 32 + 8 * fq;
#pragma unroll
        for (int ai = 0; ai < 2; ++ai)
#pragma unroll
            for (int m = 0; m < 4; ++m) { const int row = row0 + ai * HALF + m * 16; float h[8];
#pragma unroll
                for (int n = 0; n < 2; ++n)
#pragma unroll
                    for (int i = 0; i < 4; ++i) { const float a = acc[ai][0][m][n][i], b = acc[ai][1][m][n][i]; h[4 * n + i] = a * b * __builtin_amdgcn_rcpf(1.f + __expf(-a)); }
                u32x4 w; w.x = cvt_pk_bf16(h[0], h[1]); w.y = cvt_pk_bf16(h[2], h[3]); w.z = cvt_pk_bf16(h[4], h[5]); w.w = cvt_pk_bf16(h[6], h[7]);
                *(u32x4*)(O + (size_t)row * 1024 + col0) = w; }
    }
};


struct EpiEvenIn {
    static constexpr bool PERM = true, AFTER_DRAIN = false;
    bf16_t* P; bf16_t* GG; bf16_t* HQ; bf16_t* HK; bf16_t* IB; float* GB; const float* OM; const float* alog; const float* dtb;
    __device__ __forceinline__ void operator()(const f32x4 (&acc)[2][2][4][2], const Unit& u, int wr, int wc, int fr, int fq) const {
        const int row0 = u.pm * BM + wr * 64 + fr, pn = u.pn;
#pragma unroll
        for (int ai = 0; ai < 2; ++ai)
#pragma unroll
            for (int m = 0; m < 4; ++m) { const int row = row0 + ai * HALF + m * 16;
#pragma unroll
                for (int bj = 0; bj < 2; ++bj) { const int cc = bj * HALF + wc * 32 + 8 * fq; float x[8];
#pragma unroll
                    for (int i = 0; i < 4; ++i) { x[i] = acc[ai][bj][m][0][i]; x[4 + i] = acc[ai][bj][m][1][i]; }
                    bf16_t* dst = nullptr;
                    if (pn <= 5) dst = P + (size_t)row * 4864 + pn * 256 + cc;
                    else if (pn <= 7) dst = GG + (size_t)row * 1024 + (pn - 6) * 256 + cc;
                    else if (pn == 16 || pn == 17) dst = GG + (size_t)row * 1024 + 512 + (pn - 16) * 256 + cc;
                    else if (pn <= 9) { dst = HQ + (size_t)row * 512 + (pn - 8) * 256 + cc;
#pragma unroll
                        for (int i = 0; i < 8; ++i) x[i] = x[i] * __builtin_amdgcn_rcpf(1.f + __expf(-x[i])); }
                    else if (pn <= 11) dst = IB + (size_t)row * 512 + (pn - 10) * 256 + cc;
                    else if (pn <= 15) { const int z = (pn - 12) >> 1, c512 = ((pn - 12) & 1) * 256 + cc; dst = HK + (size_t)row * 1024 + z * 512 + c512;
                        const f32x4 o0 = *(const f32x4*)(OM + z * 512 + c512), o1 = *(const f32x4*)(OM + z * 512 + c512 + 4);
#pragma unroll
                        for (int i = 0; i < 8; ++i) x[i] = (i < 4 ? o0[i] : o1[i - 4]) * __builtin_amdgcn_rcpf(1.f + __expf(x[i])); }
                    else { if (cc == 0) { f32x4 g0, g1;
#pragma unroll
                            for (int i = 0; i < 8; ++i) { const float t = x[i] + dtb[i]; const float sp = t > 20.f ? t : log1pf(__expf(t)); const float gg = -__expf(alog[i]) * sp; if (i < 4) g0[i] = gg; else g1[i - 4] = gg; }
                            *(f32x4*)(GB + (size_t)row * 16) = g0; *(f32x4*)(GB + (size_t)row * 16 + 4) = g1; }
                        else if (cc == 8) { f32x4 g0, g1;
#pragma unroll
                            for (int i = 0; i < 8; ++i) { const float bb = __builtin_amdgcn_rcpf(1.f + __expf(-x[i])); if (i < 4) g0[i] = bb; else g1[i - 4] = bb; }
                            *(f32x4*)(GB + (size_t)row * 16 + 8) = g0; *(f32x4*)(GB + (size_t)row * 16 + 12) = g1; } }
                    if (dst) { u32x4 w; w.x = cvt_pk_bf16(x[0], x[1]); w.y = cvt_pk_bf16(x[2], x[3]); w.z = cvt_pk_bf16(x[4], x[5]); w.w = cvt_pk_bf16(x[6], x[7]); *(u32x4*)dst = w; } } }
    }
};
template <class Epi, class Sched, bool ALIGN_EPI = false, bool SP2 = false, bool GATHER = false>
__device__ __forceinline__ void gemm_phase(PG8_LAS unsigned char* lds, const Gemm g, const Sched& S, const Epi& E) {
    int tid_ = threadIdx.x; asm volatile("" : "+v"(tid_));
    const int tid = tid_, wid = __builtin_amdgcn_readfirstlane(tid >> 6), lane = tid & 63, wr = wid >> 2, wc = wid & 3, fr = lane & 15, fq = lane >> 4;
#if REPK == 13
    const int K = g.K, nt0 = K / BK, nt = nt0 * (g.krep ? 2 : 1);
#define PG8_KW(x) ((x) & (nt0 - 1))
#else
    const int K = g.K, nt = K / BK;
#define PG8_KW(x) (x)
#endif
    unsigned voffA[2], voffB[2];
#pragma unroll
    for (int i = 0; i < 2; ++i) { int R, C; stage_rc(tid * 16 + i * 8192, R, C); const int Rb = Epi::PERM ? ((R & ~31) + perm32(R & 31)) : R;
        voffA[i] = (unsigned)(R * K + C) * 2u; voffB[i] = (unsigned)(Rb * K + C) * 2u; }
    unsigned ogc[2][2], ogn[2][2];
    PG8_LAS int* gtab = (PG8_LAS int*)(lds + STAGE_BYTES + 2048);
    if constexpr (GATHER) { Unit uu;
        for (int i = 0; i < 12 && S.next(i, uu); ++i) if (tid < 256) { unsigned r = (unsigned)g.gidx[uu.pm * BM + tid]; gtab[i * 256 + tid] = (int)(r < (unsigned)g.grows ? r : (unsigned)(g.grows - 1)); }
        __syncthreads(); }
    auto gofs = [&](int ord, unsigned (&o)[2][2]) {
#pragma unroll
        for (int hh = 0; hh < 2; ++hh)
#pragma unroll
            for (int i = 0; i < 2; ++i) { int R, C; stage_rc(tid * 16 + i * 8192, R, C); const unsigned r = (unsigned)gtab[ord * 256 + hh * HALF + R];
                o[hh][i] = r * (unsigned)(K * 2) + (unsigned)(C * 2); } };
    const size_t kstep = (size_t)(BK * 2);
    const size_t hstep = (size_t)HALF * K * 2;
    const size_t tstep = 2 * hstep;
    const unsigned ldsw = (unsigned)wid * 1024u;
    const int aoff = lds_byte(wr * 64 + fr, fq * 8), boff = lds_byte(wc * 32 + fr, fq * 8);
#define PG8_SA(b, h) (((b) * 2 + (h)) * HTB)
#define PG8_SB(b, h) ((4 + (b) * 2 + (h)) * HTB)
#define PG8_STAGE(bufoff, gbase, voff) do { _Pragma("unroll") for (int _i = 0; _i < 2; ++_i) \
        __builtin_amdgcn_global_load_lds((const unsigned*)((const char*)(gbase) + (voff)[_i]), (PG8_LAS unsigned*)(lds + (bufoff) + ldsw + _i * 8192), 16, 0, 0); } while (0)
#define PG8_STAGE_A(bufoff, gbase, hh, nx) do { if constexpr (GATHER) { _Pragma("unroll") for (int _i = 0; _i < 2; ++_i) \
        __builtin_amdgcn_global_load_lds((const unsigned*)((const char*)(gbase) + ((nx) ? ogn[hh][_i] : ogc[hh][_i])), (PG8_LAS unsigned*)(lds + (bufoff) + ldsw + _i * 8192), 16, 0, 0); } \
        else { PG8_STAGE(bufoff, (gbase) + (hh) * hstep, voffA); } } while (0)
#define PG8_LDA(dst, b, h) do { _Pragma("unroll") for (int m = 0; m < 4; ++m) _Pragma("unroll") for (int k = 0; k < 2; ++k) dst[m][k] = *(const PG8_LAS bf16x8*)(lds + PG8_SA(b, h) + aoff + m * 2048 + k * 1024); } while (0)
#define PG8_LDB(dst, b, h) do { _Pragma("unroll") for (int n = 0; n < 2; ++n) _Pragma("unroll") for (int k = 0; k < 2; ++k) dst[n][k] = *(const PG8_LAS bf16x8*)(lds + PG8_SB(b, h) + boff + n * 2048 + k * 1024); } while (0)
#define PG8_MMA(ai, bj, At, Bt) do { __builtin_amdgcn_s_setprio(1); _Pragma("unroll") for (int m = 0; m < 4; ++m) _Pragma("unroll") for (int n = 0; n < 2; ++n) _Pragma("unroll") for (int k = 0; k < 2; ++k) \
        acc[ai][bj][m][n] = __builtin_amdgcn_mfma_f32_16x16x32_bf16(Bt[n][k], At[m][k], acc[ai][bj][m][n], 0, 0, 0); __builtin_amdgcn_s_setprio(0); } while (0)
#define PG8_WAIT_V(n) asm volatile("s_waitcnt vmcnt(" #n ")" ::: "memory")
#define PG8_WAIT_L(n) asm volatile("s_waitcnt lgkmcnt(" #n ")" ::: "memory")
#define PG8_BAR __builtin_amdgcn_s_barrier()
#define PG8_SCHED __builtin_amdgcn_sched_barrier(0)
    Unit cur, nxt; int ui = 0;
    if (!S.next(0, cur)) return;
    f32x4 acc[2][2][4][2];
#pragma unroll
    for (int a = 0; a < 2; ++a)
#pragma unroll
        for (int b = 0; b < 2; ++b)
#pragma unroll
            for (int m = 0; m < 4; ++m)
#pragma unroll
                for (int n = 0; n < 2; ++n) acc[a][b][m][n] = (f32x4){0.f, 0.f, 0.f, 0.f};
    bf16x8 At[4][2], B0[2][2], B1[2][2];
    const char* cA = (const char*)g.A + (GATHER ? (size_t)0 : (size_t)cur.pm * tstep); if constexpr (GATHER) gofs(0, ogc); const char* cB = (const char*)g.Bt + (g.gstride ? bgroup(cur.pm) * g.gstride : (size_t)0) + (size_t)cur.pn * tstep;
    S.a_ready(cur);
    if constexpr (SP2) {
        PG8_STAGE(PG8_SB(0, 0), cB, voffB); PG8_STAGE(PG8_SB(0, 1), cB + hstep, voffB); PG8_STAGE_A(PG8_SA(0, 0), cA, 0, false); PG8_STAGE_A(PG8_SA(0, 1), cA, 1, false);
        if (wr == 1) PG8_BAR;
        PG8_WAIT_V(2); PG8_BAR;
        PG8_STAGE(PG8_SB(1, 0), cB + kstep, voffB); PG8_STAGE_A(PG8_SA(1, 0), cA + kstep, 0, false); PG8_STAGE(PG8_SB(1, 1), cB + hstep + kstep, voffB);
        PG8_WAIT_V(6); PG8_BAR;
    } else {
        PG8_STAGE(PG8_SB(0, 0), cB, voffB); PG8_STAGE_A(PG8_SA(0, 0), cA, 0, false); PG8_STAGE(PG8_SB(0, 1), cB + hstep, voffB); PG8_STAGE_A(PG8_SA(0, 1), cA, 1, false);
        if (wr == 1) PG8_BAR;
        PG8_WAIT_V(4); PG8_BAR;
        PG8_STAGE(PG8_SB(1, 0), cB + kstep, voffB); PG8_STAGE_A(PG8_SA(1, 0), cA + kstep, 0, false); PG8_STAGE(PG8_SB(1, 1), cB + hstep + kstep, voffB);
        PG8_WAIT_V(6); PG8_BAR;
    }
    for (;;) {
        const bool has_next = S.next(ui + 1, nxt);
        const char* nA = has_next ? (const char*)g.A + (GATHER ? (size_t)0 : (size_t)nxt.pm * tstep) : cA; if constexpr (GATHER) { if (has_next) gofs(ui + 1, ogn); } const bool nxs_all = has_next; const char* nB = has_next ? (const char*)g.Bt + (g.gstride ? bgroup(nxt.pm) * g.gstride : (size_t)0) + (size_t)nxt.pn * tstep : cB;
        for (int t = 0; t < nt; t += 2) {
            const bool last = (t == nt - 2); const bool nxs = last && nxs_all;
            const char* a1 = cA + (size_t)PG8_KW(t + 1) * kstep;
            const char* a2 = last ? nA : cA + (size_t)PG8_KW(t + 2) * kstep; const char* b2 = last ? nB : cB + (size_t)PG8_KW(t + 2) * kstep;
            const char* a3 = a2 + kstep; const char* b3 = b2 + kstep;
            if (last && has_next) S.a_ready(nxt);
            if constexpr (SP2) {
            PG8_LDB(B0, 0, 0); PG8_LDB(B1, 0, 1); PG8_SCHED; PG8_LDA(At, 0, 0); PG8_STAGE_A(PG8_SA(1, 1), a1, 1, false);
            PG8_WAIT_V(8); PG8_WAIT_L(0); PG8_BAR; PG8_MMA(0, 0, At, B0); PG8_MMA(0, 1, At, B1); PG8_BAR; PG8_SCHED;
            PG8_LDA(At, 0, 1); PG8_STAGE(PG8_SB(0, 0), b2, voffB); PG8_STAGE(PG8_SB(0, 1), b2 + hstep, voffB); PG8_STAGE_A(PG8_SA(0, 0), a2, 0, nxs);
            PG8_WAIT_V(8); PG8_WAIT_L(0); PG8_BAR; PG8_MMA(1, 0, At, B0); PG8_MMA(1, 1, At, B1); PG8_BAR; PG8_SCHED;
            PG8_LDB(B0, 1, 0); PG8_LDB(B1, 1, 1); PG8_SCHED; PG8_LDA(At, 1, 0); PG8_STAGE_A(PG8_SA(0, 1), a2, 1, nxs);
            PG8_WAIT_V(8); PG8_WAIT_L(0); PG8_BAR; PG8_MMA(0, 0, At, B0); PG8_MMA(0, 1, At, B1); PG8_BAR; PG8_SCHED;
            PG8_LDA(At, 1, 1); PG8_STAGE(PG8_SB(1, 0), b3, voffB); PG8_STAGE(PG8_SB(1, 1), b3 + hstep, voffB); PG8_STAGE_A(PG8_SA(1, 0), a3, 0, nxs);
            PG8_WAIT_V(8); PG8_WAIT_L(0); PG8_BAR; PG8_MMA(1, 0, At, B0); PG8_MMA(1, 1, At, B1); PG8_BAR; PG8_SCHED;
            } else {
            PG8_LDB(B0, 0, 0); PG8_SCHED; PG8_LDA(At, 0, 0); PG8_STAGE_A(PG8_SA(1, 1), a1, 1, false);
            PG8_WAIT_L(8); PG8_BAR; PG8_WAIT_L(0); PG8_MMA(0, 0, At, B0); PG8_BAR; PG8_SCHED;
            PG8_LDB(B1, 0, 1); PG8_STAGE(PG8_SB(0, 0), b2, voffB);
            PG8_BAR; PG8_WAIT_L(0); PG8_MMA(0, 1, At, B1); PG8_BAR;
            PG8_LDA(At, 0, 1); PG8_STAGE_A(PG8_SA(0, 0), a2, 0, nxs);
            PG8_BAR; PG8_WAIT_L(0); PG8_MMA(1, 0, At, B0); PG8_BAR; PG8_SCHED;
            PG8_STAGE(PG8_SB(0, 1), b2 + hstep, voffB);
            PG8_WAIT_V(6); PG8_BAR; PG8_MMA(1, 1, At, B1); PG8_BAR;
            PG8_LDB(B0, 1, 0); PG8_SCHED; PG8_LDA(At, 1, 0); PG8_STAGE_A(PG8_SA(0, 1), a2, 1, nxs);
            PG8_WAIT_L(8); PG8_BAR; PG8_WAIT_L(0); PG8_MMA(0, 0, At, B0); PG8_BAR; PG8_SCHED;
            PG8_LDB(B1, 1, 1); PG8_STAGE(PG8_SB(1, 0), b3, voffB);
            PG8_BAR; PG8_WAIT_L(0); PG8_MMA(0, 1, At, B1); PG8_BAR;
            PG8_LDA(At, 1, 1); PG8_STAGE_A(PG8_SA(1, 0), a3, 0, nxs);
            PG8_BAR; PG8_WAIT_L(0); PG8_MMA(1, 0, At, B0); PG8_BAR; PG8_SCHED;
            PG8_STAGE(PG8_SB(1, 1), b3 + hstep, voffB);
            PG8_WAIT_V(6); PG8_BAR; PG8_MMA(1, 1, At, B1); PG8_BAR;
            }
        }
        if constexpr (ALIGN_EPI) { if (wr == 0) PG8_BAR; }
        if constexpr (!Epi::AFTER_DRAIN) { E(acc, cur, wr, wc, fr, fq); S.done(cur); }
        if (!has_next) break;
#pragma unroll
        for (int a = 0; a < 2; ++a)
#pragma unroll
            for (int b = 0; b < 2; ++b)
#pragma unroll
                for (int m = 0; m < 4; ++m)
#pragma unroll
                    for (int n = 0; n < 2; ++n) acc[a][b][m][n] = (f32x4){0.f, 0.f, 0.f, 0.f};
        cur = nxt; cA = nA; cB = nB; ++ui;
        if constexpr (GATHER) {
#pragma unroll
            for (int hh = 0; hh < 2; ++hh) { ogc[hh][0] = ogn[hh][0]; ogc[hh][1] = ogn[hh][1]; } }
        if constexpr (ALIGN_EPI) { if (wr == 1) PG8_BAR; }
    }
    PG8_WAIT_V(0);
    if constexpr (!ALIGN_EPI) { if (wr == 0) PG8_BAR; }
    PG8_BAR;
    if constexpr (Epi::AFTER_DRAIN) { E.fused(acc, cur, wr, wc, fr, fq, lds, wid, lane); S.done(cur); }
#undef PG8_KW
#undef PG8_SA
#undef PG8_SB
#undef PG8_STAGE
#undef PG8_STAGE_A
#undef PG8_LDA
#undef PG8_LDB
#undef PG8_MMA
#undef PG8_WAIT_V
#undef PG8_WAIT_L
#undef PG8_BAR
#undef PG8_SCHED
}
}

constexpr int NWAVES = 8, NTHR = 512;
constexpr int DM = 1024, NB = 4, SEQ = 8192, CTXL = 256, NLAT = NB * SEQ, NCTX = NB * CTXL, ROWS = NLAT + NCTX;
constexpr int DEPTH = 4, NE = 16, FF = 1024;
constexpr int PE = 4864;
constexpr int PO = 1792;
constexpr int CAP_L = 1024, CAP_C = 32;
constexpr int NSLOT_L = NE * NB * CAP_L  , NSLOT_ALL = NSLOT_L + NE * 256  ;
constexpr int VTLEN = 8448;
constexpr float EPS = 1e-6f;

constexpr size_t MiB = 1u << 20;
constexpr size_t WS_CTL = 0, CTL_ZERO_BYTES = 1 * MiB;
constexpr size_t WS_MOD = 1 * MiB;
constexpr size_t WS_OMT = 1 * MiB + 512 * 1024;
constexpr size_t WS_AFF = 2 * MiB;
constexpr size_t WS_INV = 5 * MiB;
constexpr size_t WS_GB = 8 * MiB;
constexpr size_t WS_IDX = 11 * MiB;
constexpr size_t WS_GATES = 12 * MiB;
constexpr size_t WS_VT = 13 * MiB;
constexpr size_t WS_WIN = 22 * MiB;
constexpr size_t WS_WOUT = 32 * MiB;
constexpr size_t WS_W13 = 34 * MiB;
constexpr size_t WS_W2 = 98 * MiB;
constexpr size_t WS_X = 130 * MiB;
constexpr size_t WS_HN = 262 * MiB;
constexpr size_t WS_P = 328 * MiB;
constexpr size_t WS_PREP = 664 * MiB;
constexpr size_t WS_ODIR = 862 * MiB;
constexpr size_t WS_IB = 994 * MiB;
constexpr size_t WS_END = 1027 * MiB;
constexpr size_t WS_XS = WS_P, WS_HID = WS_P + 136 * MiB, WS_Y2 = WS_PREP;
constexpr size_t WS_QKVN = WS_PREP, WS_HQ = WS_PREP + 99 * MiB, WS_HK = WS_PREP + 132 * MiB;
constexpr size_t WS_LA = WS_PREP, WS_U = WS_PREP + 66 * MiB;
constexpr size_t WS_TA = WS_ODIR, WS_TH = WS_ODIR + 4 * MiB, WS_CARRY = WS_ODIR + 8 * MiB;
static_assert((size_t)ROWS * PE * 2 <= 314 * MiB && (size_t)NSLOT_ALL * 1024 * 2 <= 136 * MiB && (size_t)ROWS * 1536 * 2 <= 99 * MiB && (size_t)ROWS * 1024 * 2 <= 66 * MiB, "ws map");
constexpr int CW_BAR = 4096;

constexpr int RING_BYTES = 131072, LDS_BYTES = 147456, MISC_OFF = LDS_BYTES - 1024, PTR_OFF = LDS_BYTES - 512;

#define GAS __attribute__((address_space(1)))
#define LAS __attribute__((address_space(3)))
typedef unsigned short bf16;
typedef unsigned v4u __attribute__((ext_vector_type(4)));
typedef unsigned v2u __attribute__((ext_vector_type(2)));
typedef float f32x4 __attribute__((ext_vector_type(4)));
typedef short bf16x8 __attribute__((ext_vector_type(8)));
typedef short s16x4 __attribute__((ext_vector_type(4)));
#define VM_WAIT() asm volatile("s_waitcnt vmcnt(0)" ::: "memory")
#define MFMA16(a, b, c) __builtin_amdgcn_mfma_f32_16x16x32_bf16((a), (b), (c), 0, 0, 0)

typedef float f32x2_t __attribute__((ext_vector_type(2))); typedef __bf16 bf16x2_t __attribute__((ext_vector_type(2)));
__device__ __forceinline__ unsigned pk2(float lo, float hi) { f32x2_t v = {lo, hi}; bf16x2_t b = __builtin_convertvector(v, bf16x2_t); return __builtin_bit_cast(unsigned, b); }
__device__ __forceinline__ unsigned f2bf(float f) { return pk2(f, 0.f) & 0xffffu; }
__device__ __forceinline__ float bflo(unsigned u) { return __builtin_bit_cast(float, u << 16); }
__device__ __forceinline__ float bfhi(unsigned u) { return __builtin_bit_cast(float, u & 0xffff0000u); }
__device__ __forceinline__ float bf1(bf16 u) { return __builtin_bit_cast(float, (unsigned)u << 16); }
__device__ __forceinline__ void unpack8(const v4u w, float (&f)[8]) { f[0] = bflo(w.x); f[1] = bfhi(w.x); f[2] = bflo(w.y); f[3] = bfhi(w.y); f[4] = bflo(w.z); f[5] = bfhi(w.z); f[6] = bflo(w.w); f[7] = bfhi(w.w); }
__device__ __forceinline__ v4u pack8(const float (&f)[8]) { v4u w; w.x = pk2(f[0], f[1]); w.y = pk2(f[2], f[3]); w.z = pk2(f[4], f[5]); w.w = pk2(f[6], f[7]); return w; }
__device__ __forceinline__ float sigmoidf_(float x) { return __builtin_amdgcn_rcpf(1.f + __expf(-x)); }
__device__ __forceinline__ float siluf_(float x) { return x * sigmoidf_(x); }
__device__ __forceinline__ float softplusf_(float x) { return x > 20.f ? x : log1pf(__expf(x)); }
__device__ __forceinline__ float wave_sum(float v) {
#pragma unroll
    for (int o = 1; o < 64; o <<= 1) v += __shfl_xor(v, o);
    return v;
}
__device__ __forceinline__ float dppf(float v, const int ctrl_sel) {
    const int b = __builtin_bit_cast(int, v); int r;
    if (ctrl_sel == 0) r = __builtin_amdgcn_update_dpp(0, b, 0xB1, 0xF, 0xF, true);
    else if (ctrl_sel == 1) r = __builtin_amdgcn_update_dpp(0, b, 0x4E, 0xF, 0xF, true);
    else if (ctrl_sel == 2) r = __builtin_amdgcn_update_dpp(0, b, 0x141, 0xF, 0xF, true);
    else r = __builtin_amdgcn_update_dpp(0, b, 0x140, 0xF, 0xF, true);
    return __builtin_bit_cast(float, r);
}
__device__ __forceinline__ float row16_sum(float v) {
    v += dppf(v, 0); v += dppf(v, 1); v += dppf(v, 2); v += dppf(v, 3); return v;
}

#define XB_TMO      128
#define XB_XCNT(j)  (256  + 64 * (j))
#define XB_XSUB(j)  (1280 + 64 * (j))
#define XB_XGEN(j)  (2304 + 64 * (j))
#define XB_TOP      3328
#define XB_TOPGEN   3392
#define XCD_BAR_WORDS 3456
#define XB_SPIN_CAP (1u << 22)
__device__ __forceinline__ unsigned xb_ld(unsigned* p)              { return __hip_atomic_load(p, __ATOMIC_RELAXED, __HIP_MEMORY_SCOPE_AGENT); }
__device__ __forceinline__ unsigned xb_add(unsigned* p, unsigned v) { return __hip_atomic_fetch_add(p, v, __ATOMIC_RELAXED, __HIP_MEMORY_SCOPE_AGENT); }
__device__ __forceinline__ unsigned xb_xcc_id() { return (unsigned)__builtin_amdgcn_s_getreg((3 << 11) | 20) & 0xFu; }
#define XB_SPIN(cond, bar) do { unsigned _sp = 0; while (cond) { __builtin_amdgcn_s_sleep(1); \
    if ((++_sp & 255u) == 0u) { if (xb_ld(&(bar)[XB_TMO])) break; if (_sp > XB_SPIN_CAP) { atomicAdd(&(bar)[XB_TMO], 1u); break; } } } } while (0)
struct XcdBarrier { unsigned* bar; unsigned x; volatile LAS unsigned* st; };
__device__ __forceinline__ XcdBarrier xcd_barrier_post(unsigned* bar, volatile LAS unsigned* st) {
    XcdBarrier b; b.bar = bar; b.x = xb_xcc_id(); b.st = st;
    if (threadIdx.x == 0) (void)xb_add(&bar[XB_XCNT(b.x)], 1u);
    return b;
}
__device__ __forceinline__ void xcd_barrier_complete(unsigned* bar, unsigned x, unsigned& nloc, unsigned& nx) {
    const unsigned G = gridDim.x * gridDim.y * gridDim.z;
    unsigned sum, cnt, mine, sp = 0u;
    for (;;) {
        sum = 0u; cnt = 0u; mine = 0u;
#pragma unroll
        for (unsigned j = 0; j < 16; ++j) { const unsigned c = xb_ld(&bar[XB_XCNT(j)]); sum += c; cnt += (c > 0u) ? 1u : 0u; mine = (j == x) ? c : mine; }
        if (sum == G) break;
        __builtin_amdgcn_s_sleep(1);
        if ((++sp & 255u) == 0u) { if (xb_ld(&bar[XB_TMO])) break; if (sp > XB_SPIN_CAP) { atomicAdd(&bar[XB_TMO], 1u); break; } }
    }
    nloc = mine > 0u ? mine : 1u; nx = cnt > 0u ? cnt : 1u;
}
__device__ __forceinline__ void xcd_barrier(const XcdBarrier& b) {
    asm volatile("s_waitcnt vmcnt(0)" ::: "memory");
    __syncthreads();
    if (threadIdx.x == 0) {
        unsigned* bar = b.bar;
        __builtin_amdgcn_s_waitcnt(0);
        unsigned nloc = b.st[0], nx = b.st[1];
        if (nloc == 0u) { xcd_barrier_complete(bar, b.x, nloc, nx); b.st[0] = nloc; b.st[1] = nx; }
        const unsigned old = xb_add(&bar[XB_XSUB(b.x)], 1u);
        const unsigned gen = old / nloc;
        if (old + 1u == (gen + 1u) * nloc) {
            __builtin_amdgcn_fence(__ATOMIC_RELEASE, "agent");
            asm volatile("s_waitcnt vmcnt(0)" ::: "memory");
            const unsigned og = xb_add(&bar[XB_TOP], 1u);
            const unsigned tg = og / nx;
            if (og + 1u == (tg + 1u) * nx) xb_add(&bar[XB_TOPGEN], 1u);
            else XB_SPIN(xb_ld(&bar[XB_TOPGEN]) == tg, bar);
            __builtin_amdgcn_fence(__ATOMIC_ACQUIRE, "agent");
            xb_add(&bar[XB_XGEN(b.x)], 1u);
            asm volatile("s_waitcnt vmcnt(0)" ::: "memory");
        } else {
            XB_SPIN(xb_ld(&bar[XB_XGEN(b.x)]) == gen, bar);
            __builtin_amdgcn_fence(__ATOMIC_ACQUIRE, "agent");
            asm volatile("s_waitcnt vmcnt(0)" ::: "memory");
        }
    }
    __syncthreads();
}

struct Frame {
    LAS unsigned char* lds;
    int tid, lane, wave, G, wg;
    float* out;
    unsigned char* ws;
};
#define WSP(T, off) ((T*)(F.ws + (off)))
#define INP(i) (((const float* const LAS*)(F.lds + PTR_OFF))[i])
__device__ __forceinline__ int row_vi(int row) { return row < NLAT ? (row >> 13) : 4; }
__device__ __forceinline__ int seq_lo(int row) { return row < NLAT ? (row & ~(SEQ - 1)) : (row & ~(CTXL - 1)); }
__device__ __forceinline__ int seq_hi(int row) { return row < NLAT ? (row | (SEQ - 1)) + 1 : (row | (CTXL - 1)) + 1; }

__device__ __attribute__((noinline)) void phase_mod(Frame F) {
    LAS float* sv = (LAS float*)F.lds;
    LAS float* red = (LAS float*)(F.lds + 20480);
    const float* c = INP(1); const float* cc = INP(3);
    for (int i = F.tid; i < 5 * 1024; i += NTHR) { const int v = i >> 10, k = i & 1023; const float x = v < 4 ? c[v * 1024 + k] : cc[k]; sv[i] = siluf_(x); }
    __syncthreads();
    if (F.wg == 0) for (int i = F.tid; i < 2 * 1024; i += NTHR) { const int jl = i >> 10, r = i & 1023; const float* lbl = INP(15);
        WSP(float, WS_OMT)[i] = jl == 0 ? 1.f : 1.f - sigmoidf_(lbl[1024 + r] - lbl[r]); }
    const int c4 = F.tid & 15, kg = F.tid >> 4;
    for (int u = F.wg; u < 4 * 96; u += F.G) {
        const int l = u / 96, n0 = (u % 96) * 64;
        const float* W = INP(4) + (size_t)l * 1024 * 6144;
        f32x4 acc[5];
#pragma unroll
        for (int v = 0; v < 5; ++v) acc[v] = (f32x4){0.f, 0.f, 0.f, 0.f};
#pragma unroll 4
        for (int kk = 0; kk < 32; ++kk) { const int k = kg * 32 + kk; const f32x4 w = *(const f32x4*)(W + (size_t)k * 6144 + n0 + 4 * c4);
#pragma unroll
            for (int v = 0; v < 5; ++v) acc[v] += w * sv[v * 1024 + k]; }
#pragma unroll
        for (int v = 0; v < 5; ++v)
#pragma unroll
            for (int i = 0; i < 4; ++i) red[(kg * 5 + v) * 64 + 4 * c4 + i] = acc[v][i];
        __syncthreads();
        if (F.tid < 320) { const int v = F.tid >> 6, col = F.tid & 63; float s = 0.f;
            for (int g = 0; g < 32; ++g) s += red[(g * 5 + v) * 64 + col];
            WSP(float, WS_MOD)[((size_t)l * 5 + v) * 6144 + n0 + col] = s + INP(5)[l * 6144 + n0 + col]; }
        __syncthreads();
    }
}

struct TDesc { const float* src; int ld, k0, sc, ncv; bf16* dst; int drow; };
__device__ __forceinline__ TDesc wdesc(Frame& F, int l, int it) {
    const int jl = l >> 1; const bool even = !(l & 1);
    const int ntn_in = even ? PE / 64 : PO / 64;
    const int I0 = 16 * ntn_in, I1 = 256, I2 = 16 * 16 * 32;
    TDesc d; int r = it;
    if (r < I0) { const int kt = r / ntn_in, nt = r % ntn_in, n0 = nt * 64; d.k0 = kt * 64; d.dst = WSP(bf16, WS_WIN); d.drow = n0;
        if (even) { d.src = INP(9) + (size_t)jl * 1024 * 4624; d.ld = 4624;
            if (n0 < 2048) { d.sc = n0; d.ncv = 64; } else if (n0 < 4608) { d.sc = n0 + 16; d.ncv = 64; } else if (n0 == 4608) { d.sc = 2048; d.ncv = 16; } else { d.sc = 0; d.ncv = 0; } }
        else { d.src = INP(17) + (size_t)jl * 1024 * 1792; d.ld = 1792; d.sc = n0; d.ncv = 64; }
        return d; }
    r -= I0;
    if (r < I1) { const int kt = r >> 4, nt = r & 15; d.src = (even ? INP(10) : INP(18)) + (size_t)jl * 1024 * 1024; d.ld = 1024; d.k0 = kt * 64; d.sc = nt * 64; d.ncv = 64; d.dst = WSP(bf16, WS_WOUT); d.drow = nt * 64; return d; }
    r -= I1;
    if (r < I2) { const int e = r >> 9, kt = (r >> 5) & 15, nt = r & 31, jt = nt >> 2, half = (nt >> 1) & 1, sub = nt & 1;
        d.src = (half ? INP(29) : INP(28)) + ((size_t)l * NE + e) * 1024 * 1024; d.ld = 1024; d.k0 = kt * 64; d.sc = jt * 128 + sub * 64; d.ncv = 64; d.dst = WSP(bf16, WS_W13) + (size_t)e * 2048 * 1024; d.drow = nt * 64; return d; }
    r -= I2;
    { const int e = r >> 8, kt = (r >> 4) & 15, nt = r & 15;
        d.src = INP(30) + ((size_t)l * NE + e) * 1024 * 1024; d.ld = 1024; d.k0 = kt * 64; d.sc = nt * 64; d.ncv = 64; d.dst = WSP(bf16, WS_W2) + (size_t)e * 1024 * 1024; d.drow = nt * 64; return d; }
}
__device__ __forceinline__ int witems_w2(int l) { return 16 * (!(l & 1) ? PE / 64 : PO / 64) + 256 + 16 * 16 * 32; }
__device__ __attribute__((noinline)) void phase_weights(Frame F, int l, int it0, int NI, int wg0) {
    if (F.wg < wg0) return;
    const int r = F.tid >> 4, c4 = F.tid & 15, n = F.tid >> 3, kc = F.tid & 7;
    __syncthreads();
    for (int base = it0 + (F.wg - wg0) * 4; base < NI; base += (F.G - wg0) * 4) {
        f32x4 v[4][2]; TDesc d[4];
#pragma unroll
        for (int t = 0; t < 4; ++t) { v[t][0] = (f32x4){0.f, 0.f, 0.f, 0.f}; v[t][1] = v[t][0];
            if (base + t < NI) { d[t] = wdesc(F, l, base + t);
                if (4 * c4 < d[t].ncv) { v[t][0] = *(const f32x4*)(d[t].src + (size_t)(d[t].k0 + r) * d[t].ld + d[t].sc + 4 * c4); v[t][1] = *(const f32x4*)(d[t].src + (size_t)(d[t].k0 + 32 + r) * d[t].ld + d[t].sc + 4 * c4); } } }
#pragma unroll
        for (int t = 0; t < 4; ++t) { LAS float* scr = (LAS float*)(F.lds + t * 16640);
#pragma unroll
            for (int hh = 0; hh < 2; ++hh) { const int k = hh * 32 + r; scr[k * 65 + 4 * c4 + 0] = v[t][hh][0]; scr[k * 65 + 4 * c4 + 1] = v[t][hh][1]; scr[k * 65 + 4 * c4 + 2] = v[t][hh][2]; scr[k * 65 + 4 * c4 + 3] = v[t][hh][3]; } }
        __syncthreads();
#pragma unroll
        for (int t = 0; t < 4; ++t) if (base + t < NI) { const LAS float* scr = (const LAS float*)(F.lds + t * 16640); float f[8];
#pragma unroll
            for (int j = 0; j < 8; ++j) f[j] = scr[(8 * kc + j) * 65 + n];
            *(v4u*)(d[t].dst + (size_t)(d[t].drow + n) * 1024 + d[t].k0 + 8 * kc) = pack8(f); }
        __syncthreads();
    }
}

__device__ __forceinline__ void load_row_bf(const bf16* p, int lane, f32x4 (&v)[4]) {
#pragma unroll
    for (int j = 0; j < 4; ++j) { const v2u w = *(const v2u*)(p + 4 * lane + 256 * j); v[j] = (f32x4){bflo(w.x), bfhi(w.x), bflo(w.y), bfhi(w.y)}; }
}
__device__ __forceinline__ void store_row_bf(bf16* p, int lane, const f32x4 (&v)[4]) {
#pragma unroll
    for (int j = 0; j < 4; ++j) { v2u o; o.x = pk2(v[j][0], v[j][1]); o.y = pk2(v[j][2], v[j][3]); *(v2u*)(p + 4 * lane + 256 * j) = o; }
}
__device__ __forceinline__ void load_row(const float* p, int lane, f32x4 (&v)[4]) {
#pragma unroll
    for (int j = 0; j < 4; ++j) v[j] = *(const f32x4*)(p + 4 * lane + 256 * j);
}
constexpr int NPICK = 3;
struct CombBuf { v2u w[NPICK][4]; float wk[NPICK]; unsigned long long rest; };
__device__ __forceinline__ size_t comb_slot(int row, int e, int c) { return row < NLAT ? ((size_t)(e * 4 + (row >> 13)) * CAP_L + c) : ((size_t)NSLOT_L + e * 256 + ((row - NLAT) >> 8) * CAP_C + c); }
__device__ __forceinline__ void comb_issue(Frame& F, int row, int myc, CombBuf& cb) {
    const bf16* Y2 = WSP(bf16, WS_Y2); const float* GT = WSP(float, WS_GATES);
    unsigned long long mask = __ballot(myc >= 0);
#pragma unroll
    for (int k = 0; k < NPICK; ++k) { const bool ok = mask != 0ull; const int e = ok ? __builtin_ctzll(mask) : 0; mask &= mask - 1;
        const int c = ok ? __shfl(myc, e) : 0; const size_t slot = comb_slot(row, e, c); const bf16* yp = Y2 + slot * 1024; const float gt = GT[slot]; cb.wk[k] = ok ? gt : 0.f;
#pragma unroll
        for (int j = 0; j < 4; ++j) cb.w[k][j] = *(const v2u*)(yp + 4 * F.lane + 256 * j); }
    cb.rest = mask;
}
__device__ __forceinline__ void comb_finish(Frame& F, const LAS float* g2, int row, int myc, const CombBuf& cb, f32x4 (&v)[4]) {
    const bf16* Y2 = WSP(bf16, WS_Y2); const float* GT = WSP(float, WS_GATES);
    f32x4 s[4];
#pragma unroll
    for (int j = 0; j < 4; ++j) s[j] = (f32x4){0.f, 0.f, 0.f, 0.f};
#pragma unroll
    for (int k = 0; k < NPICK; ++k)
#pragma unroll
        for (int j = 0; j < 4; ++j) { s[j][0] += cb.wk[k] * bflo(cb.w[k][j].x); s[j][1] += cb.wk[k] * bfhi(cb.w[k][j].x); s[j][2] += cb.wk[k] * bflo(cb.w[k][j].y); s[j][3] += cb.wk[k] * bfhi(cb.w[k][j].y); }
    unsigned long long mask = cb.rest;
    while (mask) {
        const int e = __builtin_ctzll(mask); mask &= mask - 1;
        const int c = __shfl(myc, e); const size_t slot = comb_slot(row, e, c); const bf16* yp = Y2 + slot * 1024; const float gt = GT[slot];
#pragma unroll
        for (int j = 0; j < 4; ++j) { const v2u w = *(const v2u*)(yp + 4 * F.lane + 256 * j); s[j][0] += gt * bflo(w.x); s[j][1] += gt * bfhi(w.x); s[j][2] += gt * bflo(w.y); s[j][3] += gt * bfhi(w.y); }
    }
#pragma unroll
    for (int j = 0; j < 4; ++j) v[j] += s[j] * *(const LAS f32x4*)(g2 + 4 * F.lane + 256 * j);
}
__device__ __forceinline__ float row_rstd(const f32x4 (&v)[4]) {
    float s = 0.f;
#pragma unroll
    for (int j = 0; j < 4; ++j) s += (v[j][0] * v[j][0] + v[j][1] * v[j][1]) + (v[j][2] * v[j][2] + v[j][3] * v[j][3]);
    return __builtin_amdgcn_rsqf(wave_sum(s) * (1.f / DM) + EPS);
}
__device__ __attribute__((noinline)) void phase_rp1(Frame F, int l) {
    const int gw = F.wg * NWAVES + F.wave, NGW = F.G * NWAVES;
    LAS float* TA_ = (LAS float*)F.lds; LAS float* TB_ = TA_ + 5 * 1024; LAS float* TG_ = TB_ + 5 * 1024;
    { const float* nw = INP(6) + l * 1024;
      for (int i = F.tid; i < 5 * 1024; i += NTHR) { const int vi = i >> 10, c = i & 1023; const float* md = WSP(float, WS_MOD) + ((size_t)l * 5 + vi) * 6144;
          TA_[i] = nw[c] * (1.f + md[1024 + c]); TB_[i] = md[c]; TG_[i] = l > 0 ? WSP(float, WS_MOD)[((size_t)(l - 1) * 5 + vi) * 6144 + 5120 + c] : 0.f; }
      __syncthreads(); }
    const float* x0 = INP(0); const float* xc0 = INP(2);
    auto ldx = [&](int row, f32x4 (&v)[4]) { if (l == 0) load_row(row < NLAT ? x0 + (size_t)row * 1024 : xc0 + (size_t)(row - NLAT) * 1024, F.lane, v); else load_row_bf(WSP(bf16, WS_X) + (size_t)row * 1024, F.lane, v); };
    auto clampr = [&](int r) -> int { return r < ROWS ? r : ROWS - 1; };
    auto ldinv = [&](int r) -> int { return (l > 0 && F.lane < 16) ? WSP(int, WS_INV)[(size_t)clampr(r) * 16 + F.lane] : -1; };
    f32x4 vn[4]; CombBuf cbn; int c0 = -1, c1 = -1;
    if (gw < ROWS) { ldx(gw, vn); c0 = ldinv(gw); c1 = ldinv(gw + NGW); if (l > 0) comb_issue(F, gw, c0, cbn); }
    for (int row = gw; row < ROWS; row += NGW) {
        f32x4 v[4]; CombBuf cb = cbn; const int myc = c0;
#pragma unroll
        for (int j = 0; j < 4; ++j) v[j] = vn[j];
        const int rn = clampr(row + NGW);
        ldx(rn, vn);
        if (l > 0) comb_issue(F, rn, c1, cbn);
        c0 = c1; c1 = ldinv(row + 2 * NGW);
        if (l > 0) { comb_finish(F, TG_ + row_vi(row) * 1024, row, myc, cb, v); store_row_bf(WSP(bf16, WS_X) + (size_t)row * 1024, F.lane, v); }
        const float rs = row_rstd(v);
        const LAS float* ta = TA_ + row_vi(row) * 1024; const LAS float* tb = TB_ + row_vi(row) * 1024;
        bf16* hp = WSP(bf16, WS_HN) + (size_t)row * 1024;
#pragma unroll
        for (int j = 0; j < 4; ++j) { const int col = 4 * F.lane + 256 * j; const f32x4 a = *(const LAS f32x4*)(ta + col), sh = *(const LAS f32x4*)(tb + col);
            const f32x4 h = (v[j] * rs) * a + sh; v2u o; o.x = pk2(h[0], h[1]); o.y = pk2(h[2], h[3]); *(v2u*)(hp + col) = o; }
    }
}
__device__ __forceinline__ float row16_max(float v) { v = fmaxf(v, dppf(v, 0)); v = fmaxf(v, dppf(v, 1)); v = fmaxf(v, dppf(v, 2)); v = fmaxf(v, dppf(v, 3)); return v; }
__device__ __attribute__((noinline)) void phase_rp2(Frame F, int l) {
    constexpr int HP = 2064;
    LAS float* TA_ = (LAS float*)F.lds; LAS float* TB_ = TA_ + 5 * 1024;
    LAS unsigned char* HH = F.lds + 40960; LAS unsigned char* HL = HH + 16 * HP; LAS float* PART = (LAS float*)(HL + 16 * HP);
    static_assert(40960 + 2 * 16 * HP + 8 * 16 * 17 * 4 <= MISC_OFF, "rp2 LDS map");
    { const float* nw = INP(7) + l * 1024;
      for (int i = F.tid; i < 5 * 1024; i += NTHR) { const int vi = i >> 10, c = i & 1023; const float* md = WSP(float, WS_MOD) + ((size_t)l * 5 + vi) * 6144; TA_[i] = nw[c] * (1.f + md[4096 + c]); TB_[i] = md[3072 + c]; } }
    const int li = F.lane & 15, lq = F.lane >> 4, w = F.wave;
    bf16x8 bh[4], bl[4];
    { const float* R = INP(27) + (size_t)l * 1024 * 16;
#pragma unroll
      for (int s = 0; s < 4; ++s) { unsigned hi[4], lo[4];
#pragma unroll
          for (int j2 = 0; j2 < 4; ++j2) { const int k = 128 * w + 32 * s + 8 * lq + 2 * j2; const float r0 = R[(size_t)k * 16 + li], r1 = R[(size_t)(k + 1) * 16 + li];
              hi[j2] = pk2(r0, r1); lo[j2] = pk2(r0 - bflo(hi[j2]), r1 - bfhi(hi[j2])); }
          bh[s] = __builtin_bit_cast(bf16x8, (v4u){hi[0], hi[1], hi[2], hi[3]}); bl[s] = __builtin_bit_cast(bf16x8, (v4u){lo[0], lo[1], lo[2], lo[3]}); } }
    __syncthreads();
    const int nrows = (l == DEPTH - 1) ? NLAT : ROWS, nblk = nrows >> 4;
    v2u nx[2][4];
    auto ldraw = [&](int blk) { const int b2 = blk < nblk ? blk : nblk - 1;
#pragma unroll
        for (int q = 0; q < 2; ++q) { const bf16* pp = WSP(bf16, WS_X) + (size_t)(16 * b2 + 2 * w + q) * 1024 + 4 * F.lane;
#pragma unroll
            for (int j = 0; j < 4; ++j) nx[q][j] = *(const v2u*)(pp + 256 * j); } };
    ldraw(F.wg);
    for (int blk = F.wg; blk < nblk; blk += F.G) {
        f32x4 h[2][4];
#pragma unroll
        for (int q = 0; q < 2; ++q)
#pragma unroll
            for (int j = 0; j < 4; ++j) h[q][j] = (f32x4){bflo(nx[q][j].x), bfhi(nx[q][j].x), bflo(nx[q][j].y), bfhi(nx[q][j].y)};
        ldraw(blk + F.G);
#pragma unroll
        for (int q = 0; q < 2; ++q) { const int row = 16 * blk + 2 * w + q;
            const float rs = row_rstd(h[q]);
            const LAS float* ta = TA_ + row_vi(row) * 1024; const LAS float* tb = TB_ + row_vi(row) * 1024;
            bf16* hp = WSP(bf16, WS_HN) + (size_t)row * 1024;
#pragma unroll
            for (int j = 0; j < 4; ++j) { const int col = 4 * F.lane + 256 * j; const f32x4 a = *(const LAS f32x4*)(ta + col), sh = *(const LAS f32x4*)(tb + col);
                const f32x4 x = (h[q][j] * rs) * a + sh; v2u o; o.x = pk2(x[0], x[1]); o.y = pk2(x[2], x[3]); *(v2u*)(hp + col) = o;
                v2u ol; ol.x = pk2(x[0] - bflo(o.x), x[1] - bfhi(o.x)); ol.y = pk2(x[2] - bflo(o.y), x[3] - bfhi(o.y));
                *(LAS v2u*)(HH + (2 * w + q) * HP + col * 2) = o; *(LAS v2u*)(HL + (2 * w + q) * HP + col * 2) = ol; } }
        __syncthreads();
        { f32x4 acc = (f32x4){0.f, 0.f, 0.f, 0.f};
#pragma unroll
          for (int s = 0; s < 4; ++s) { const int ko = (128 * w + 32 * s + 8 * lq) * 2;
              const bf16x8 ah = *(const LAS bf16x8*)(HH + li * HP + ko), al = *(const LAS bf16x8*)(HL + li * HP + ko);
              acc = MFMA16(ah, bh[s], acc); acc = MFMA16(al, bh[s], acc); acc = MFMA16(ah, bl[s], acc); }
#pragma unroll
          for (int r = 0; r < 4; ++r) PART[(w * 16 + 4 * lq + r) * 17 + li] = acc[r]; }
        __syncthreads();
        if (F.tid < 256) { const int rr = F.tid >> 4, e = F.tid & 15, row = 16 * blk + rr; float lg = 0.f;
#pragma unroll
            for (int k = 0; k < 8; ++k) lg += PART[(k * 16 + rr) * 17 + e];
            const float mx = row16_max(lg), ex = __expf(lg - mx), den = row16_sum(ex);
            float* dst = row < NLAT ? WSP(float, WS_AFF) + ((size_t)((row >> 13) * 16 + e)) * SEQ + (row & (SEQ - 1)) : WSP(float, WS_AFF) + (size_t)NB * 16 * SEQ + ((size_t)(((row - NLAT) >> 8) * 16 + e)) * CTXL + ((row - NLAT) & (CTXL - 1));
            *dst = ex / den; }
    }
}
__device__ __attribute__((noinline)) void phase_final(Frame F) {
    const int gw = F.wg * NWAVES + F.wave, NGW = F.G * NWAVES;
    const float* nw = INP(8);
    LAS float* TG_ = (LAS float*)F.lds;
    for (int i = F.tid; i < 4 * 1024; i += NTHR) TG_[i] = WSP(float, WS_MOD)[((size_t)(DEPTH - 1) * 5 + (i >> 10)) * 6144 + 5120 + (i & 1023)];
    __syncthreads();
    auto clampr = [&](int r) -> int { return r < NLAT ? r : NLAT - 1; };
    auto ldinv = [&](int r) -> int { return F.lane < 16 ? WSP(int, WS_INV)[(size_t)clampr(r) * 16 + F.lane] : -1; };
    f32x4 vn[4]; CombBuf cbn; int c0 = -1, c1 = -1;
    if (gw < NLAT) { load_row_bf(WSP(bf16, WS_X) + (size_t)gw * 1024, F.lane, vn); c0 = ldinv(gw); c1 = ldinv(gw + NGW); comb_issue(F, gw, c0, cbn); }
    for (int row = gw; row < NLAT; row += NGW) {
        f32x4 v[4]; CombBuf cb = cbn; const int myc = c0;
#pragma unroll
        for (int j = 0; j < 4; ++j) v[j] = vn[j];
        const int rn = clampr(row + NGW);
        load_row_bf(WSP(bf16, WS_X) + (size_t)rn * 1024, F.lane, vn);
        comb_issue(F, rn, c1, cbn);
        c0 = c1; c1 = ldinv(row + 2 * NGW);
        comb_finish(F, TG_ + (row >> 13) * 1024, row, myc, cb, v);
        const float rs = row_rstd(v);
        float* op = F.out + (size_t)row * 1024;
#pragma unroll
        for (int j = 0; j < 4; ++j) { const int col = 4 * F.lane + 256 * j; *(f32x4*)(op + col) = v[j] * rs * *(const f32x4*)(nw + col); }
    }
}

__device__ __forceinline__ bf16x8 frag_rm(const LAS unsigned char* base, int pitchB, int row0, int k0, int lane) {
    return *(const LAS bf16x8*)(base + (row0 + (lane & 15)) * pitchB + (k0 + 8 * (lane >> 4)) * 2);
}
__device__ __forceinline__ bf16x8 frag_tr(const LAS unsigned char* base, int pitchB, int krow0, int col0, int lane) {
    const int g = lane >> 4, i = lane & 15, qp = i >> 2, p = i & 3;
    const LAS unsigned char* a = base + (krow0 + 8 * g + qp) * pitchB + (col0 + 4 * p) * 2;
    const s16x4 lo = __builtin_bit_cast(s16x4, __builtin_amdgcn_ds_read_tr16_b64_v4i16((LAS s16x4*)a));
    const s16x4 hi = __builtin_bit_cast(s16x4, __builtin_amdgcn_ds_read_tr16_b64_v4i16((LAS s16x4*)(a + 4 * pitchB)));
    return (bf16x8){lo[0], lo[1], lo[2], lo[3], hi[0], hi[1], hi[2], hi[3]};
}
constexpr int NCHUNK = ROWS / 64  , NCU = NCHUNK * 4 * 2  ;
constexpr int LP = 272;
constexpr size_t CH_DU = WS_P, CH_DW = WS_P + 66 * MiB, CH_HQE = WS_P + 132 * MiB, CH_HKE = WS_P + 198 * MiB, CH_DQK = WS_P + 264 * MiB, CH_HA = WS_P + 297 * MiB,
                 CH_DCUM = WS_P + 330 * MiB, CH_HD = WS_P + 332 * MiB;
static_assert((size_t)NCU * 64 * 128 * 2 == 66 * MiB && (size_t)NCU * 64 * 64 * 2 == 33 * MiB && (size_t)NCU * 128 * 4 <= 3 * MiB, "chunk output map");

__device__ __attribute__((noinline)) void phase_even_prep(Frame F, int l) {
    const int jl = l >> 1;
    const int gw = F.wg * NWAVES + F.wave, NGW = F.G * NWAVES;
    const bf16* P = WSP(bf16, WS_P);
    const float* cw = INP(11) + (size_t)jl * 4 * 1536;
    for (int u = gw; u < NCHUNK * 3; u += NGW) {
        const int rb = u / 3, g = u - rb * 3, r0 = rb * 64, lo = seq_lo(r0), hi = seq_hi(r0);
        const int ch = g * 512 + F.lane * 8;
        float w[4][8];
#pragma unroll
        for (int j = 0; j < 4; ++j) { const f32x4 w0 = *(const f32x4*)(cw + j * 1536 + ch), w1 = *(const f32x4*)(cw + j * 1536 + ch + 4);
            w[j][0] = w0[0]; w[j][1] = w0[1]; w[j][2] = w0[2]; w[j][3] = w0[3]; w[j][4] = w1[0]; w[j][5] = w1[1]; w[j][6] = w1[2]; w[j][7] = w1[3]; }
        auto ld = [&](int t) -> v4u { const int row = r0 - 1 + t; const bool ok = (row >= lo) & (row < hi); const int rc = row < lo ? lo : (row >= hi ? hi - 1 : row);
            const v4u x = *(const v4u*)(P + (size_t)rc * PE + ch); v4u zz; zz.x = ok ? x.x : 0u; zz.y = ok ? x.y : 0u; zz.z = ok ? x.z : 0u; zz.w = ok ? x.w : 0u; return zz; };
        float win[4][8]; v4u pk[4];
#pragma unroll
        for (int t = 0; t < 4; ++t) unpack8(ld(t), win[t]);
#pragma unroll
        for (int t = 4; t < 8; ++t) pk[t & 3] = ld(t);
        bf16* dst = WSP(bf16, WS_QKVN) + (size_t)r0 * 1536 + ch;
#pragma unroll 4
        for (int i = 0; i < 64; ++i) {
            float a[8]; float ss = 0.f;
#pragma unroll
            for (int k = 0; k < 8; ++k) { float v = w[0][k] * win[i & 3][k] + w[1][k] * win[(i + 1) & 3][k] + w[2][k] * win[(i + 2) & 3][k] + w[3][k] * win[(i + 3) & 3][k]; v = siluf_(v); a[k] = v; ss += v * v; }
            if (g < 2) { ss = row16_sum(ss); const float rs = __builtin_amdgcn_rsqf(ss + EPS) * (g == 0 ? 0.08838834764831845f : 1.f);
#pragma unroll
                for (int k = 0; k < 8; ++k) a[k] *= rs; }
            *(v4u*)(dst + (size_t)i * 1536) = pack8(a);
            unpack8(pk[i & 3], win[i & 3]);
            pk[i & 3] = ld(i + 8);
        }
    }
}
constexpr int DC_Q = 0, DC_K = 17408, DC_V = 34816, DC_KK = 52224, DC_QK = 69632, DC_TB = 87040, DC_TBE = 96256, DC_CUM = 105472, DC_BETA = 105728, DC_PA = 105984, DC_PB = 115200, DC_XA = DC_QK, DC_XB = DC_Q;
struct ChunkRegs { v4u t[6]; float g, b; };
__device__ __forceinline__ void chunk_delta_load(Frame& F, int cu, int tid, ChunkRegs& R) {
    const int z = cu & 1, h = (cu >> 1) & 3, r0 = (cu >> 3) * 64;
    const int tau = tid >> 3, c8 = tid & 7; const size_t row = (size_t)(r0 + (z ? 63 - tau : tau)); const bf16* src = WSP(bf16, WS_QKVN) + row * 1536 + h * 128;
#pragma unroll
    for (int hh = 0; hh < 2; ++hh) { const int col = hh * 64 + c8 * 8; R.t[hh] = *(const v4u*)(src + col); R.t[2 + hh] = *(const v4u*)(src + 512 + col); R.t[4 + hh] = *(const v4u*)(src + 1024 + col); }
    const int ts = tid & 63; const float* gb = WSP(float, WS_GB) + (size_t)(r0 + (z ? 63 - ts : ts)) * 16; R.g = gb[z * 4 + h]; R.b = gb[8 + z * 4 + h];
}
__device__ __forceinline__ void chunk_delta(Frame& F, int cu, int cu_next, ChunkRegs& R) {
    const int z = cu & 1, h = (cu >> 1) & 3, chunkId = cu >> 3, r0 = chunkId * 64;
    int tid = F.tid; asm volatile("" : "+v"(tid));
    const int lane = tid & 63, w = F.wave;
    LAS unsigned char* L = F.lds;
    LAS float* KKf = (LAS float*)(L + DC_KK); LAS float* QKf = (LAS float*)(L + DC_QK); LAS float* cum = (LAS float*)(L + DC_CUM); LAS float* bet = (LAS float*)(L + DC_BETA);
    __syncthreads();
    { const int tau = tid >> 3, c8 = tid & 7;
#pragma unroll
      for (int hh = 0; hh < 2; ++hh) { const int col = hh * 64 + c8 * 8;
          *(LAS v4u*)(L + DC_Q + tau * LP + col * 2) = R.t[hh]; *(LAS v4u*)(L + DC_K + tau * LP + col * 2) = R.t[2 + hh]; *(LAS v4u*)(L + DC_V + tau * LP + col * 2) = R.t[4 + hh]; } }
    float c = R.g; const float bt = R.b;
    chunk_delta_load(F, cu_next, tid, R);
    {
#pragma unroll
        for (int o = 1; o < 64; o <<= 1) { const float t = __shfl_up(c, o); if (lane >= o) c += t; }
        if (w == 0) { cum[lane] = c; bet[lane] = bt; WSP(float, CH_DCUM)[(size_t)cu * 64 + lane] = c; }
    }
    __syncthreads();
#pragma unroll
    for (int tt = 0; tt < 2; ++tt) { const int t = 2 * w + tt, mt = t >> 2, nt = t & 3;
        f32x4 ak = (f32x4){0.f, 0.f, 0.f, 0.f}, aq = ak;
#pragma unroll
        for (int s = 0; s < 4; ++s) { const bf16x8 b = frag_rm(L + DC_K, LP, 16 * nt, 32 * s, lane);
            ak = MFMA16(frag_rm(L + DC_K, LP, 16 * mt, 32 * s, lane), b, ak); aq = MFMA16(frag_rm(L + DC_Q, LP, 16 * mt, 32 * s, lane), b, aq); }
#pragma unroll
        for (int r = 0; r < 4; ++r) { const int i = 16 * mt + 4 * (lane >> 4) + r, j = 16 * nt + (lane & 15); KKf[i * 68 + j] = ak[r]; QKf[i * 68 + j] = aq[r]; } }
    __syncthreads();
    { const int i = tid >> 3, j0 = (tid & 7) * 8; const float ci = cum[i], bi = bet[i]; float qv[8];
#pragma unroll
      for (int jj = 0; jj < 8; ++jj) { const int j = j0 + jj; const float d = (j <= i) ? __expf(ci - cum[j]) : 0.f;
          KKf[i * 68 + j] = (j < i) ? bi * KKf[i * 68 + j] * d : 0.f; qv[jj] = QKf[i * 68 + j] * d; QKf[i * 68 + j] = 0.f; }
      *(v4u*)(WSP(bf16, CH_DQK) + ((size_t)cu * 64 + i) * 64 + j0) = pack8(qv); }
    LAS float* TL = (LAS float*)(L + DC_QK); LAS float* YL = (LAS float*)(L + DC_Q);
    __syncthreads();
    if (w == 0) { const int bb = lane >> 4, c = lane & 15; float t[16];
#pragma unroll
        for (int i = 0; i < 16; ++i) { float a0 = 0.f, a1 = 0.f;
#pragma unroll
            for (int j4 = 0; j4 < (i + 3) / 4; ++j4) { const f32x4 m4 = *(const LAS f32x4*)(KKf + (16 * bb + i) * 68 + 16 * bb + 4 * j4);
#pragma unroll
                for (int e2 = 0; e2 < 4; ++e2) if (4 * j4 + e2 < i) { if (e2 & 1) a1 += m4[e2] * t[4 * j4 + e2]; else a0 += m4[e2] * t[4 * j4 + e2]; } }
            t[i] = ((i == c) ? 1.f : 0.f) - (a0 + a1); TL[(16 * bb + i) * 68 + 16 * bb + c] = t[i]; } }
    __syncthreads();
#pragma unroll 1
    for (int lev = 1; lev <= 3; ++lev) {
        const int nb = 4 - lev;
        for (int e2 = tid; e2 < nb * 256; e2 += NTHR) { const int bj = e2 >> 8, bi = bj + lev, i = (e2 >> 4) & 15, j = e2 & 15; float acc = 0.f;
            float a1 = 0.f, a2 = 0.f, a3 = 0.f;
            for (int k = 16 * bj; k < 16 * bi; k += 4) { const f32x4 m4 = *(const LAS f32x4*)(KKf + (16 * bi + i) * 68 + k);
                acc += m4[0] * TL[k * 68 + 16 * bj + j]; a1 += m4[1] * TL[(k + 1) * 68 + 16 * bj + j]; a2 += m4[2] * TL[(k + 2) * 68 + 16 * bj + j]; a3 += m4[3] * TL[(k + 3) * 68 + 16 * bj + j]; }
            YL[(bj * 16 + i) * 17 + j] = (acc + a1) + (a2 + a3); }
        __syncthreads();
        for (int e2 = tid; e2 < nb * 256; e2 += NTHR) { const int bj = e2 >> 8, bi = bj + lev, i = (e2 >> 4) & 15, j = e2 & 15; float acc = 0.f;
#pragma unroll
            for (int k = 0; k < 16; k += 4) { const f32x4 d4 = *(const LAS f32x4*)(TL + (16 * bi + i) * 68 + 16 * bi + k);
                acc += (d4[0] * YL[(bj * 16 + k) * 17 + j] + d4[1] * YL[(bj * 16 + k + 1) * 17 + j]) + (d4[2] * YL[(bj * 16 + k + 2) * 17 + j] + d4[3] * YL[(bj * 16 + k + 3) * 17 + j]); }
            TL[(16 * bi + i) * 68 + 16 * bj + j] = -acc; }
        __syncthreads();
    }
    { LAS bf16* tb = (LAS bf16*)(L + DC_TB); LAS bf16* tbe = (LAS bf16*)(L + DC_TBE);
      const int i = tid >> 3, j0 = (tid & 7) * 8; float t1[8], t2[8];
#pragma unroll
      for (int jj = 0; jj < 8; ++jj) { const int j = j0 + jj; const float tv = TL[i * 68 + j], bc = bet[j]; t1[jj] = tv * bc; t2[jj] = tv * bc * __expf(cum[j]); }
      *(LAS v4u*)(tb + i * 72 + j0) = pack8(t1); *(LAS v4u*)(tbe + i * 72 + j0) = pack8(t2); }
    __syncthreads();
    { bf16* DU = WSP(bf16, CH_DU) + (size_t)cu * 8192; bf16* DW = WSP(bf16, CH_DW) + (size_t)cu * 8192;
      bf16x8 av[2], ak2[2];
#pragma unroll
      for (int s = 0; s < 2; ++s) { av[s] = frag_tr(L + DC_V, LP, 32 * s, 16 * w, lane); ak2[s] = frag_tr(L + DC_K, LP, 32 * s, 16 * w, lane); }
#pragma unroll
      for (int nt = 0; nt < 4; ++nt) { f32x4 au = (f32x4){0.f, 0.f, 0.f, 0.f}, aw = au;
#pragma unroll
          for (int s = 0; s < 2; ++s) { au = MFMA16(av[s], frag_rm(L + DC_TB, 144, 16 * nt, 32 * s, lane), au); aw = MFMA16(ak2[s], frag_rm(L + DC_TBE, 144, 16 * nt, 32 * s, lane), aw); }
          const int i = 16 * nt + (lane & 15), n = 16 * w + 4 * (lane >> 4);
          v2u o; o.x = pk2(au[0], au[1]); o.y = pk2(au[2], au[3]); *(LAS v2u*)(L + DC_KK + i * LP + n * 2) = o;
          o.x = pk2(aw[0], aw[1]); o.y = pk2(aw[2], aw[3]); *(LAS v2u*)(L + DC_QK + i * LP + n * 2) = o; }
      __syncthreads();
      { const int tau = tid >> 3, c8 = tid & 7;
#pragma unroll
        for (int hh = 0; hh < 2; ++hh) { const int col = hh * 64 + c8 * 8;
            *(v4u*)(DU + tau * 128 + col) = *(const LAS v4u*)(L + DC_KK + tau * LP + col * 2); *(v4u*)(DW + tau * 128 + col) = *(const LAS v4u*)(L + DC_QK + tau * LP + col * 2); } } }
}

constexpr int HC_Q = 0, HC_K = 17408, HC_ELL = 34816, HC_REF = 68608, HC_TOT = 70656, HC_KI = 72704;
__device__ __forceinline__ void chunk_hgrn_load(Frame& F, int cu, int tid, ChunkRegs& R) {
    const int z = cu & 1, h = (cu >> 1) & 3, r0 = (cu >> 3) * 64;
    const int tau = tid >> 3, c8 = tid & 7; const size_t row = (size_t)(r0 + (z ? 63 - tau : tau));
#pragma unroll
    for (int hh = 0; hh < 2; ++hh) { const int col = hh * 64 + c8 * 8; R.t[hh] = *(const v4u*)(WSP(bf16, WS_HQ) + row * 512 + h * 128 + col); R.t[2 + hh] = *(const v4u*)(WSP(bf16, WS_HK) + row * 1024 + z * 512 + h * 128 + col); }
}
__device__ __forceinline__ void chunk_hgrn(Frame& F, int cu, int cu_next, ChunkRegs& R) {
    const int z = cu & 1, h = (cu >> 1) & 3, chunkId = cu >> 3, r0 = chunkId * 64;
    int tid = F.tid; asm volatile("" : "+v"(tid));
    const int lane = tid & 63, w = F.wave;
    LAS unsigned char* L = F.lds;
    LAS float* ell = (LAS float*)(L + HC_ELL); LAS float* ref = (LAS float*)(L + HC_REF); LAS float* tot = (LAS float*)(L + HC_TOT);
    __syncthreads();
    { const int tau = tid >> 3, c8 = tid & 7;
#pragma unroll
      for (int hh = 0; hh < 2; ++hh) { const int col = hh * 64 + c8 * 8; *(LAS v4u*)(L + HC_Q + tau * LP + col * 2) = R.t[hh]; *(LAS v4u*)(L + HC_K + tau * LP + col * 2) = R.t[2 + hh]; } }
    chunk_hgrn_load(F, cu_next, tid, R);
    __syncthreads();
    { const int I = tid >> 7, d = tid & 127; float c = 0.f;
#pragma unroll
      for (int t = 0; t < 16; ++t) { const float kk = bf1(*(const LAS bf16*)(L + HC_K + (16 * I + t) * LP + d * 2)); c += __logf(1.f - kk); ell[(16 * I + t) * 132 + d] = c; }
      tot[I * 128 + d] = c; }
    __syncthreads();
    { const int I = tid >> 7, d = tid & 127; float r = 0.f;
      for (int i2 = 0; i2 < I; ++i2) r += tot[i2 * 128 + d];
      ref[I * 128 + d] = r; }
    __syncthreads();
    { const int tau = tid >> 3, c8 = tid & 7, I = tau >> 4;
#pragma unroll
      for (int hh = 0; hh < 2; ++hh) { const int d0 = hh * 64 + c8 * 8; float q[8], k[8], qt[8], qe[8], ke[8];
          unpack8(*(const LAS v4u*)(L + HC_Q + tau * LP + d0 * 2), q); unpack8(*(const LAS v4u*)(L + HC_K + tau * LP + d0 * 2), k);
          float bb[8];
#pragma unroll
          for (int e = 0; e < 8; ++e) { const int d = d0 + e; const float el = ell[tau * 132 + d]; const float b = ref[I * 128 + d] + el; const float bL = ref[3 * 128 + d] + ell[63 * 132 + d];
              bb[e] = b; qt[e] = q[e] * __expf(el); qe[e] = q[e] * __expf(b); ke[e] = k[e] * __expf(bL - b);
              if (tau == 0) WSP(float, CH_HD)[(size_t)cu * 128 + d] = __expf(bL); }
          *(LAS v4u*)(L + HC_Q + tau * LP + d0 * 2) = pack8(qt);
          *(v4u*)(WSP(bf16, CH_HQE) + ((size_t)cu * 64 + tau) * 128 + d0) = pack8(qe);
          *(v4u*)(WSP(bf16, CH_HKE) + ((size_t)cu * 64 + tau) * 128 + d0) = pack8(ke);
#pragma unroll
          for (int I2 = 0; I2 < 4; ++I2) if (I2 >= I) { float ki[8];
#pragma unroll
              for (int e = 0; e < 8; ++e) ki[e] = k[e] * __expf(fminf(ref[I2 * 128 + d0 + e] - bb[e], 80.f));
              *(LAS v4u*)(L + HC_KI + (8 * I2 * (I2 + 1) + tau) * LP + d0 * 2) = pack8(ki); } } }
    __syncthreads();
    { bf16* HA = WSP(bf16, CH_HA) + (size_t)cu * 4096;
      for (int t = w; t < 16; t += 8) { const int I2 = t >> 2, J = t & 3;
          f32x4 a = (f32x4){0.f, 0.f, 0.f, 0.f};
          if (J <= I2) {
#pragma unroll
              for (int s = 0; s < 4; ++s) a = MFMA16(frag_rm(L + HC_KI, LP, 8 * I2 * (I2 + 1) + 16 * J, 32 * s, lane), frag_rm(L + HC_Q, LP, 16 * I2, 32 * s, lane), a); }
          const int i = 16 * I2 + (lane & 15), j = 16 * J + 4 * (lane >> 4);
          v2u o; o.x = pk2(j <= i ? a[0] : 0.f, j + 1 <= i ? a[1] : 0.f); o.y = pk2(j + 2 <= i ? a[2] : 0.f, j + 3 <= i ? a[3] : 0.f);
          *(v2u*)(HA + i * 64 + j) = o; } }
}
__device__ __attribute__((noinline)) void phase_even_chunk_d(Frame F) {
    if (F.wg >= NCU) return;
    ChunkRegs R; chunk_delta_load(F, F.wg, F.tid, R);
    for (int u = F.wg; u < NCU; u += F.G) chunk_delta(F, u, u + F.G < NCU ? u + F.G : u, R);
    __syncthreads(); }
__device__ __attribute__((noinline)) void phase_even_chunk_h(Frame F) {
    const int w0 = (F.wg + (F.G >> 1)) % F.G;
    if (w0 >= NCU) return;
    ChunkRegs R; chunk_hgrn_load(F, w0, F.tid, R);
    for (int u = w0; u < NCU; u += F.G) chunk_hgrn(F, u, u + F.G < NCU ? u + F.G : u, R);
    __syncthreads(); }

constexpr int SB_A = 0, SB_B = 16384, SB_C = 32768, SB_QK = 49152, SB_U = 57344, SB_CUM = 61440, SB_SZ = 61952;
constexpr int SS_ST = 2 * SB_SZ, SS_VT = SS_ST + 8704, SS_VST = SS_VT + 4608, SS_OB = SS_VST + 4608;
constexpr int SS_JUNK = SS_OB + 4096;
static_assert(SS_JUNK + 256 <= MISC_OFF, "scan LDS map");
template <int MIX>
__device__ __forceinline__ void scan_chunks(Frame& F, int chain, int slice) {
    const int b = chain >> 3, z = (chain >> 2) & 1, h = chain & 3, dv0 = slice * 32;
    int tid = F.tid; asm volatile("" : "+v"(tid)); int lane = tid & 63, li = lane & 15, lq = lane >> 4; const int w = F.wave;
    LAS unsigned char* L = F.lds;
    bf16* odst = (z == 0 ? WSP(bf16, WS_HN) : WSP(bf16, WS_ODIR) + (size_t)ROWS * 1024) + MIX * 512 + h * 128 + dv0;
    auto chunk_of = [&](int blk) -> int { return blk < 4 ? 512 + b * 4 + (z ? 3 - blk : blk) : b * 128 + (z ? 127 - (blk - 4) : (blk - 4)); };
#define DMA16(src, dst) __builtin_amdgcn_global_load_lds((const unsigned*)(src), (LAS unsigned*)(dst), 16, 0, 0)
#define DMA4(src, dst) __builtin_amdgcn_global_load_lds((const unsigned*)(src), (LAS unsigned*)(dst), 4, 0, 0)
    unsigned oA[2], oB[2], oQK, oU, oCUM;
#pragma unroll
    for (int i = 0; i < 2; ++i) { const int kk = w + 8 * i, r = 4 * kk + (lane >> 4), c = (lane & 15) ^ (r & 15);
        oA[i] = (unsigned)(r * 128 + c * 8) * 2u; oB[i] = (unsigned)((z ? 63 - r : r) * 1536 + h * 128 + c * 8) * 2u; }
    { const int r = 8 * w + (lane >> 3), c = (lane & 7) ^ ((r >> 1) & 7); oQK = (unsigned)(r * 64 + c * 8) * 2u; }
    { const int r = 16 * (w & 3) + (lane >> 2), c = lane & 3;
      oU = MIX == 0 ? (unsigned)(r * 128 + dv0 + c * 8) * 2u : (unsigned)((z ? 63 - r : r) * 512 + h * 128 + dv0 + c * 8) * 2u; }
    oCUM = (unsigned)(MIX == 0 ? lane : (w & 1) * 64 + lane) * 4u;
    auto gload = [&](int blk_, int buf) {
        const int blk = blk_ < 131 ? blk_ : 131;
        const int chunkId = chunk_of(blk); const size_t cu = ((size_t)chunkId * 4 + h) * 2 + z; const size_t r0 = (size_t)chunkId * 64;
        LAS unsigned char* D = L + buf * SB_SZ;
        const char* bA = (const char*)(MIX == 0 ? WSP(bf16, CH_DW) : WSP(bf16, CH_HQE)) + cu * (64 * 128 * 2);
        const char* bB = MIX == 0 ? (const char*)WSP(bf16, WS_QKVN) + r0 * (1536 * 2) : (const char*)WSP(bf16, CH_HKE) + cu * (64 * 128 * 2);
        const char* bQ = (const char*)(MIX == 0 ? WSP(bf16, CH_DQK) : WSP(bf16, CH_HA)) + cu * (64 * 64 * 2);
        const char* bU = MIX == 0 ? (const char*)WSP(bf16, CH_DU) + cu * (64 * 128 * 2) : (const char*)WSP(bf16, WS_IB) + r0 * (512 * 2);
        const char* bC = MIX == 0 ? (const char*)WSP(float, CH_DCUM) + cu * (64 * 4) : (const char*)WSP(float, CH_HD) + cu * (128 * 4);
#pragma unroll
        for (int i = 0; i < 2; ++i) { const int kk = w + 8 * i;
            DMA16(bA + oA[i], D + SB_A + kk * 1024);
            if (MIX == 0) { DMA16(bB + oB[i], D + SB_B + kk * 1024); DMA16(bB + 1024 + oB[i], D + SB_C + kk * 1024); }
            else DMA16(bB + oA[i], D + SB_B + kk * 1024); }
        DMA16(bQ + oQK, D + SB_QK + w * 1024);
        if (w < 4) DMA16(bU + oU, D + SB_U + w * 1024);
        if (MIX == 0) { if (w == 4) DMA4(bC + oCUM, D + SB_CUM); }
        else { if (w == 4 || w == 5) DMA4(bC + oCUM, D + SB_CUM + (w - 4) * 256); }
    };
    int psel; unsigned oP;
    if (w < 2) { const int row = w * 32 + (lane >> 1), half = lane & 1;
        if (MIX == 0) { psel = slice; oP = slice == 0 ? (unsigned)(row * 256 + half * 128) : slice == 3 ? (unsigned)(lane * 128) : (unsigned)((z ? 63 - row : row) * 3072 + h * 256 + half * 128 + (slice == 2 ? 1024 : 0)); }
        else { psel = slice == 0 ? 0 : slice == 1 ? 1 : slice == 2 ? 3 : 5; oP = slice < 2 ? (unsigned)(row * 256 + half * 128) : slice == 2 ? (unsigned)(lane * 128) : 0u; } }
    else if (w == 2) { psel = 4; oP = MIX == 0 ? (unsigned)(lane * 256 + dv0 * 2) : (unsigned)((z ? 63 - lane : lane) * 1024 + h * 256 + dv0 * 2); }
    else { psel = 5; oP = w == 3 ? (unsigned)((lane & (MIX == 0 ? 1 : 3)) * 128) : 0u; }
    psel = __builtin_amdgcn_readfirstlane(psel);
    auto pfetch = [&](int blk_) {
        const int blk = blk_ < 131 ? blk_ : 131;
        const int chunkId = chunk_of(blk); const size_t cu = ((size_t)chunkId * 4 + h) * 2 + z; const size_t r0 = (size_t)chunkId * 64;
        const char* bA = (const char*)(MIX == 0 ? WSP(bf16, CH_DW) : WSP(bf16, CH_HQE)) + cu * (64 * 128 * 2);
        const char* bB = MIX == 0 ? (const char*)WSP(bf16, WS_QKVN) + r0 * (1536 * 2) : (const char*)WSP(bf16, CH_HKE) + cu * (64 * 128 * 2);
        const char* bQ = (const char*)(MIX == 0 ? WSP(bf16, CH_DQK) : WSP(bf16, CH_HA)) + cu * (64 * 64 * 2);
        const char* bU = MIX == 0 ? (const char*)WSP(bf16, CH_DU) + cu * (64 * 128 * 2) : (const char*)WSP(bf16, WS_IB) + r0 * (512 * 2);
        const char* bC = MIX == 0 ? (const char*)WSP(float, CH_DCUM) + cu * (64 * 4) : (const char*)WSP(float, CH_HD) + cu * (128 * 4);
        const char* pb = psel == 0 ? bA : (psel == 1 || psel == 2) ? bB : psel == 3 ? bQ : psel == 4 ? bU : bC;
        DMA4(pb + oP, L + SS_JUNK);
    };
    f32x4 S[2];
    S[0] = (f32x4){0.f, 0.f, 0.f, 0.f}; S[1] = S[0];
    __syncthreads();
    for (int i = tid; i < 32 * 136 / 2; i += NTHR) ((LAS unsigned*)(L + SS_ST))[i] = 0u;
    gload(0, 0); pfetch(1);
    asm volatile("s_waitcnt vmcnt(0) lgkmcnt(0)" ::: "memory"); __builtin_amdgcn_s_barrier(); asm volatile("" ::: "memory");
    const int mt = w >> 1, nt = w & 1;
#define LDF(p) (*(const LAS bf16x8*)(p))
#define TRR(p) ({ v2u _r; asm volatile("ds_read_b64_tr_b16 %0, %1" : "=v"(_r) : "v"((unsigned)(size_t)(p))); _r; })
#define TRW4(a, b, c, d) asm volatile("s_waitcnt lgkmcnt(0)" : "+v"(a), "+v"(b), "+v"(c), "+v"(d))
#define TRJ(lo, hi) __builtin_bit_cast(bf16x8, (v4u){(lo).x, (lo).y, (hi).x, (hi).y})
    auto ostore = [&](int blk) {
        if (tid < 256) { const int r0 = chunk_of(blk) * 64, tau = tid >> 2, c = tid & 3; *(v4u*)(odst + (size_t)(r0 + (z ? 63 - tau : tau)) * 1024 + c * 8) = *(const LAS v4u*)(L + SS_OB + tau * 64 + c * 16); } };
#define SCHED_FENCE __builtin_amdgcn_sched_barrier(0)
    for (int blk = 0; blk < 132; ++blk) {
        LAS unsigned char* D = L + (blk & 1) * SB_SZ;
        const LAS float* cumL = (const LAS float*)(D + SB_CUM);
        const int qp = li >> 2, pp = li & 3;
        LAS unsigned char* aST = L + SS_ST + li * LP + lq * 16; LAS unsigned char* a144 = L + li * 144 + lq * 16;
        f32x4 oacc = (f32x4){0.f, 0.f, 0.f, 0.f};
        if (MIX == 0) {
            gload(blk + 1, (blk + 1) & 1);
            SCHED_FENCE;
            bf16x8 fS[4], fW[4], fQ[4];
            { const LAS unsigned char* pW = D + SB_A + (16 * mt + li) * 256; const LAS unsigned char* pQ = D + SB_B + (16 * mt + li) * 256; LAS unsigned char* pS = aST + nt * (16 * LP);
#pragma unroll
              for (int s = 0; s < 4; ++s) { const int so = ((4 * s + lq) ^ li) << 4; fS[s] = LDF(pS + 64 * s); fW[s] = LDF(pW + so); fQ[s] = LDF(pQ + so); } }
            const float cL = cumL[63]; const f32x4 ct4 = *(const LAS f32x4*)(cumL + 16 * mt + 4 * lq); float u4[4];
#pragma unroll
            for (int r = 0; r < 4; ++r) u4[r] = bf1(*(const LAS bf16*)(D + SB_U + (16 * mt + 4 * lq + r) * 64 + (16 * nt + li) * 2));
            SCHED_FENCE;
            f32x4 aW = oacc, aQ = oacc;
#pragma unroll
            for (int s = 0; s < 4; ++s) { aW = MFMA16(fW[s], fS[s], aW); aQ = MFMA16(fQ[s], fS[s], aQ); }
            SCHED_FENCE;
            if (blk > 0) ostore(blk - 1);
            pfetch(blk + 2);
            SCHED_FENCE;
            float vn[4], vs[4];
#pragma unroll
            for (int r = 0; r < 4; ++r) { vn[r] = u4[r] - aW[r]; vs[r] = vn[r] * __expf(cL - ct4[r]); oacc[r] = aQ[r] * __expf(ct4[r]); }
            const float gl = __expf(cL);
            { v2u o; o.x = pk2(vn[0], vn[1]); o.y = pk2(vn[2], vn[3]); *(LAS v2u*)(L + SS_VT + (16 * nt + li) * 144 + (16 * mt + 4 * lq) * 2) = o;
              o.x = pk2(vs[0], vs[1]); o.y = pk2(vs[2], vs[3]); *(LAS v2u*)(L + SS_VST + (16 * nt + li) * 144 + (16 * mt + 4 * lq) * 2) = o; }
            asm volatile("s_waitcnt lgkmcnt(0)" ::: "memory"); __builtin_amdgcn_s_barrier(); asm volatile("" ::: "memory");
            v2u kr[2][2]; bf16x8 fV[2][2], fA[2], fT[2];
#pragma unroll
            for (int s = 0; s < 2; ++s) { const int r = 32 * s + 8 * lq + qp; const LAS unsigned char* p0 = D + SB_C + r * 256 + (((2 * w + (pp >> 1)) ^ (r & 15)) << 4) + (pp & 1) * 8;
                const int r4 = r + 4; const LAS unsigned char* p1 = D + SB_C + r4 * 256 + (((2 * w + (pp >> 1)) ^ (r4 & 15)) << 4) + (pp & 1) * 8;
                kr[s][0] = TRR(p0); kr[s][1] = TRR(p1); }
#pragma unroll
            for (int n2 = 0; n2 < 2; ++n2) { fV[n2][0] = LDF(a144 + SS_VST + n2 * (16 * 144)); fV[n2][1] = LDF(a144 + SS_VST + n2 * (16 * 144) + 64); }
            { const int r = 16 * mt + li; const LAS unsigned char* pA = D + SB_QK + r * 128; LAS unsigned char* pV = a144 + SS_VT + nt * (16 * 144);
              fA[0] = LDF(pA + ((lq ^ ((r >> 1) & 7)) << 4)); fA[1] = LDF(pA + (((4 + lq) ^ ((r >> 1) & 7)) << 4)); fT[0] = LDF(pV); fT[1] = LDF(pV + 64); }
            SCHED_FENCE;
            TRW4(kr[0][0], kr[0][1], kr[1][0], kr[1][1]);
            const bf16x8 kT0 = TRJ(kr[0][0], kr[0][1]), kT1 = TRJ(kr[1][0], kr[1][1]);
            f32x4 a0 = S[0] * gl, a1 = S[1] * gl;
            a0 = MFMA16(kT0, fV[0][0], a0); a1 = MFMA16(kT0, fV[1][0], a1); oacc = MFMA16(fA[0], fT[0], oacc);
            a0 = MFMA16(kT1, fV[0][1], a0); a1 = MFMA16(kT1, fV[1][1], a1); oacc = MFMA16(fA[1], fT[1], oacc);
            S[0] = a0; S[1] = a1;
        } else {
            bf16x8 fQ[4], fS[4], fA[2]; v2u vr[4][2], kr[2][2];
            { const LAS unsigned char* pA = D + SB_A + (16 * mt + li) * 256; LAS unsigned char* pS = aST + nt * (16 * LP);
#pragma unroll
              for (int s = 0; s < 4; ++s) { fQ[s] = LDF(pA + (((4 * s + lq) ^ li) << 4)); fS[s] = LDF(pS + 64 * s); } }
            const LAS unsigned char* pV = D + SB_U + (8 * lq + qp) * 64 + pp * 8;
#pragma unroll
            for (int q4 = 0; q4 < 4; ++q4) { const LAS unsigned char* pq = pV + (q4 & 1) * (32 * 64) + (q4 >> 1) * 32; vr[q4][0] = TRR(pq); vr[q4][1] = TRR(pq + 4 * 64); }
#pragma unroll
            for (int s = 0; s < 2; ++s) { const int r = 32 * s + 8 * lq + qp; const LAS unsigned char* p0 = D + SB_B + r * 256 + (((2 * w + (pp >> 1)) ^ (r & 15)) << 4) + (pp & 1) * 8;
                const int r4 = r + 4; const LAS unsigned char* p1 = D + SB_B + r4 * 256 + (((2 * w + (pp >> 1)) ^ (r4 & 15)) << 4) + (pp & 1) * 8;
                kr[s][0] = TRR(p0); kr[s][1] = TRR(p1); }
            { const int r = 16 * mt + li; const LAS unsigned char* pA = D + SB_QK + r * 128; fA[0] = LDF(pA + ((lq ^ ((r >> 1) & 7)) << 4)); fA[1] = LDF(pA + (((4 + lq) ^ ((r >> 1) & 7)) << 4)); }
            const f32x4 dd = *(const LAS f32x4*)(cumL + 16 * w + 4 * lq);
            SCHED_FENCE;
            gload(blk + 1, (blk + 1) & 1);
            SCHED_FENCE;
            TRW4(vr[0][0], vr[0][1], vr[1][0], vr[1][1]); TRW4(vr[2][0], vr[2][1], vr[3][0], vr[3][1]); TRW4(kr[0][0], kr[0][1], kr[1][0], kr[1][1]);
            const bf16x8 v00 = TRJ(vr[0][0], vr[0][1]), v01 = TRJ(vr[1][0], vr[1][1]), v10 = TRJ(vr[2][0], vr[2][1]), v11 = TRJ(vr[3][0], vr[3][1]);
            const bf16x8 kT0 = TRJ(kr[0][0], kr[0][1]), kT1 = TRJ(kr[1][0], kr[1][1]);
            f32x4 a0 = S[0] * dd, a1 = S[1] * dd;
            oacc = MFMA16(fQ[0], fS[0], oacc); a0 = MFMA16(kT0, v00, a0); a1 = MFMA16(kT0, v10, a1);
            oacc = MFMA16(fQ[1], fS[1], oacc); a0 = MFMA16(kT1, v01, a0); a1 = MFMA16(kT1, v11, a1);
            oacc = MFMA16(fQ[2], fS[2], oacc); oacc = MFMA16(fQ[3], fS[3], oacc);
            oacc = MFMA16(fA[0], nt ? v10 : v00, oacc); oacc = MFMA16(fA[1], nt ? v11 : v01, oacc);
            S[0] = a0; S[1] = a1;
            SCHED_FENCE;
            if (blk > 0) ostore(blk - 1);
            pfetch(blk + 2);
            SCHED_FENCE;
            asm volatile("s_waitcnt lgkmcnt(0)" ::: "memory"); __builtin_amdgcn_s_barrier(); asm volatile("" ::: "memory");
        }
#pragma unroll
        for (int n2 = 0; n2 < 2; ++n2) { v2u o; o.x = pk2(S[n2][0], S[n2][1]); o.y = pk2(S[n2][2], S[n2][3]); *(LAS v2u*)(L + SS_ST + (16 * n2 + li) * LP + (16 * w + 4 * lq) * 2) = o; }
#pragma unroll
        for (int r = 0; r < 4; ++r) *(LAS bf16*)(L + SS_OB + (16 * mt + 4 * lq + r) * 64 + (16 * nt + li) * 2) = (bf16)f2bf(oacc[r]);
        asm volatile("s_waitcnt vmcnt(1) lgkmcnt(0)" ::: "memory"); __builtin_amdgcn_s_barrier(); asm volatile("" ::: "memory");
    }
    ostore(131);
    asm volatile("s_waitcnt vmcnt(0) lgkmcnt(0)" ::: "memory"); __builtin_amdgcn_s_barrier(); asm volatile("" ::: "memory");
#undef SCHED_FENCE
#undef DMA16
#undef DMA4
}
__device__ __forceinline__ void phase_even_scan_d(Frame& F) {
    for (int vw = F.wg; vw < 256; vw += F.G) { const int cm = (vw & 7) + 8 * (vw >> 5), slice = (vw >> 3) & 3, chain = cm & 31; if ((cm >> 5) == 0) scan_chunks<0>(F, chain, slice); } }
__device__ __forceinline__ void phase_even_scan_h(Frame& F) {
    for (int vw = F.wg; vw < 256; vw += F.G) { const int cm = (vw & 7) + 8 * (vw >> 5), slice = (vw >> 3) & 3, chain = cm & 31; if ((cm >> 5) == 1) scan_chunks<1>(F, chain, slice); } }
__device__ __attribute__((noinline)) void phase_even_gate(Frame F, int l) {
    const int jl = l >> 1;
    const int gw = F.wg * NWAVES + F.wave, NGW = F.G * NWAVES;
    const int nrows = (l == DEPTH - 1) ? NLAT : ROWS;
    const bf16* O0 = WSP(bf16, WS_HN); const bf16* O1 = WSP(bf16, WS_ODIR) + (size_t)ROWS * 1024; const bf16* GG = WSP(bf16, WS_ODIR);
    for (int row = gw; row < nrows; row += NGW) {
#pragma unroll
        for (int mx = 0; mx < 2; ++mx) {
            const int ch = mx * 512 + F.lane * 8; float a[8], c[8], g[8];
            unpack8(*(const v4u*)(O0 + (size_t)row * 1024 + ch), a); unpack8(*(const v4u*)(O1 + (size_t)row * 1024 + ch), c);
            unpack8(*(const v4u*)(GG + (size_t)row * 1024 + ch), g);
            float ss = 0.f;
#pragma unroll
            for (int k = 0; k < 8; ++k) { a[k] += c[k]; ss += a[k] * a[k]; }
            ss = row16_sum(ss); const float rs = __builtin_amdgcn_rsqf(ss * (1.f / 128.f) + EPS);
            const float* nw = (mx ? INP(16) : INP(14)) + jl * 128 + (F.lane & 15) * 8;
#pragma unroll
            for (int k = 0; k < 8; ++k) a[k] = a[k] * rs * nw[k] * siluf_(g[k]);
            *(v4u*)(WSP(bf16, WS_HN) + (size_t)row * 1024 + ch) = pack8(a);
        }
    }
}

__device__ __forceinline__ void rope8(float (&x)[8], float (&y)[8], int pos, int i0) {
#pragma unroll
    for (int k = 0; k < 8; ++k) { const float inv = exp2f(-(float)(i0 + k) * (13.287712379549449f / 16.f)); const float rev = (float)pos * inv * 0.15915494309189535f;
        const float fr = rev - floorf(rev); const float sn = __builtin_amdgcn_sinf(fr), cs = __builtin_amdgcn_cosf(fr);
        const float a = x[k], b = y[k]; x[k] = a * cs - b * sn; y[k] = b * cs + a * sn; }
}
__device__ __attribute__((noinline)) void phase_odd_prep(Frame F, int l) {
    const int jl = l >> 1;
    bf16* P = WSP(bf16, WS_P);
    { const long total = (long)ROWS * 40; const long gt = (long)F.wg * NTHR + F.tid, GT = (long)F.G * NTHR;
      for (long it = gt; it < total; it += GT) { const int row = (int)(it / 40), r = (int)(it % 40), hd = r >> 2, half = (r >> 1) & 1, g8 = r & 1;
          bf16* p = P + (size_t)row * PO + (hd < 8 ? hd * 64 : 512 + (hd - 8) * 64) + half * 32 + g8 * 8;
          float x[8], y[8]; unpack8(*(const v4u*)p, x); unpack8(*(const v4u*)(p + 16), y);
          if (row < NLAT) { const int t = row & (SEQ - 1); rope8(x, y, half ? (t & 63) : (t >> 6), g8 * 8); }
          if (hd < 8) {
#pragma unroll
              for (int k = 0; k < 8; ++k) { x[k] *= 0.18033688011112042f; y[k] *= 0.18033688011112042f; } }
          *(v4u*)p = pack8(x); *(v4u*)(p + 16) = pack8(y); } }
}
__device__ __attribute__((noinline)) void phase_odd_prep_bc(Frame F, int l) {
    const int jl = l >> 1;
    bf16* P = WSP(bf16, WS_P);
    { LAS unsigned char* WTb = F.lds;
      LAS unsigned char* XCb = F.lds + 36864;
      LAS float* G = (LAS float*)(F.lds + 46080);
      LAS float* segA = (LAS float*)(F.lds + 112640); LAS float* segH = (LAS float*)(F.lds + 112640 + 4096);
      const float* wr = INP(22) + (size_t)jl * 2 * 8 * 4096; const float* wi = INP(24) + (size_t)jl * 2 * 8 * 4096;
      const float* cw = INP(20) + (size_t)jl * 4 * 512; const float* cb = INP(21) + jl * 512;
      int hprev = -1;
      LAS float* CWL = (LAS float*)(F.lds + 112640 + 8192);
      v4u pre[4];
      auto ldp = [&](int u2) { const int rown = (u2 >> 3) * 64 + (F.tid >> 3), hn = u2 & 7;
#pragma unroll
          for (int jj = 0; jj < 4; ++jj) { int r2 = rown + jj - 1; r2 = r2 < 0 ? 0 : (r2 > ROWS - 1 ? ROWS - 1 : r2); pre[jj] = *(const v4u*)(P + (size_t)r2 * PO + 768 + hn * 64 + (F.tid & 7) * 8); } };
      if (F.wg < (ROWS / 64) * 8) ldp(F.wg);
      float gpar[2][3] = {{0.f, 0.f, 0.f}, {0.f, 0.f, 0.f}};
      for (int u = F.wg; u < (ROWS / 64) * 8; u += F.G) {
          const int h = u & 7, r0 = (u >> 3) * 64;
          asm volatile("" : "+v"(F.tid)); F.lane = F.tid & 63;
          const int j = 16 * (F.wave & 3) + (F.lane & 15), tg = 4 * (F.wave >> 2) + (F.lane >> 4);
          __syncthreads();
          if (h != hprev) { for (int i2 = F.tid; i2 < 4 * 4096; i2 += NTHR) { const int g = i2 >> 12, z = g & 1, ii = (i2 >> 6) & 63, jj = i2 & 63;
                  *(LAS bf16*)(WTb + (g * 64 + jj) * 144 + ii * 2) = (bf16)f2bf(((g >> 1) ? wi : wr)[((size_t)z * 8 + h) * 4096 + ii * 64 + jj]); }
              if (F.tid < 320) CWL[F.tid] = F.tid < 256 ? cw[(F.tid >> 6) * 512 + h * 64 + (F.tid & 63)] : cb[h * 64 + (F.tid - 256)];
#pragma unroll
              for (int z = 0; z < 2; ++z) { const int c = h * 64 + 16 * (F.wave & 3) + (F.lane & 15); gpar[z][0] = INP(23)[(jl * 2 + z) * 512 + c]; gpar[z][1] = INP(25)[(jl * 2 + z) * 512 + c]; gpar[z][2] = log1pf(__expf(-INP(26)[(jl * 2 + z) * 512 + c])); }
              hprev = h; __syncthreads(); }
          { const int rr = F.tid >> 3, c8 = (F.tid & 7) * 8, row = r0 + rr, lo = seq_lo(row), hi = seq_hi(row); float a[8];
#pragma unroll
            for (int k = 0; k < 8; ++k) a[k] = CWL[256 + c8 + k];
#pragma unroll
            for (int jj = 0; jj < 4; ++jj) { const int r2 = row + jj - 1; const bool ok = r2 >= lo && r2 < hi;
                float x[8]; unpack8(pre[jj], x);
#pragma unroll
                for (int k = 0; k < 8; ++k) a[k] += (ok ? CWL[jj * 64 + c8 + k] : 0.f) * x[k]; }
            *(LAS v4u*)(XCb + rr * 144 + c8 * 2) = pack8(a); }
          { const int un = u + F.G; ldp(un < (ROWS / 64) * 8 ? un : u); }
          __syncthreads();
          float acc[8][4];
          { const int w = F.wave, li = F.lane & 15, lq = F.lane >> 4, cg = w & 3, rh = w >> 2;
            bf16x8 aF[2][2];
#pragma unroll
            for (int mt = 0; mt < 2; ++mt)
#pragma unroll
                for (int s2 = 0; s2 < 2; ++s2) aF[mt][s2] = *(const LAS bf16x8*)(XCb + (32 * rh + 8 * (li >> 2) + 4 * mt + (li & 3)) * 144 + (32 * s2 + 8 * lq) * 2);
#pragma unroll
            for (int g = 0; g < 4; ++g) { const bf16x8 b0 = *(const LAS bf16x8*)(WTb + (g * 64 + 16 * cg + li) * 144 + (8 * lq) * 2), b1 = *(const LAS bf16x8*)(WTb + (g * 64 + 16 * cg + li) * 144 + (32 + 8 * lq) * 2);
#pragma unroll
                for (int mt = 0; mt < 2; ++mt) { f32x4 c4 = (f32x4){0.f, 0.f, 0.f, 0.f}; c4 = MFMA16(aF[mt][0], b0, c4); c4 = MFMA16(aF[mt][1], b1, c4);
#pragma unroll
                    for (int r = 0; r < 4; ++r) acc[4 * mt + r][g] = c4[r]; } } }
          const int c = h * 64 + j;
          float lat[2][8], ut[2][8];
#pragma unroll
          for (int z = 0; z < 2; ++z) { const float br = gpar[z][0], bi = gpar[z][1], sp = gpar[z][2];
#pragma unroll
              for (int t = 0; t < 8; ++t) { const float r = sigmoidf_(acc[t][z] + br), gi = sigmoidf_(acc[t][2 + z] + bi);
                  const float a = __expf(-8.f * sp * r); const float xc = bf1(*(const LAS bf16*)(XCb + (tg * 8 + t) * 144 + j * 2));
                  lat[z][t] = a; ut[z][t] = __builtin_amdgcn_sqrtf(fmaxf(1.f - a * a, 0.f)) * gi * xc; } }
          float hl[2][8], cd[2][8], sgA[2], sgH[2];
          { float hh = 0.f, cc = 1.f;
#pragma unroll
            for (int t = 0; t < 8; ++t) { const float a = lat[0][t]; hh = a * hh + ut[0][t]; cc *= a; hl[0][t] = hh; cd[0][t] = cc; }
            sgA[0] = cc; sgH[0] = hh; hh = 0.f; cc = 1.f;
#pragma unroll
            for (int t = 7; t >= 0; --t) { const float a = lat[1][t]; hh = a * hh + ut[1][t]; cc *= a; hl[1][t] = hh; cd[1][t] = cc; }
            sgA[1] = cc; sgH[1] = hh; }
#pragma unroll
          for (int z = 0; z < 2; ++z) { segA[(z * 8 + tg) * 64 + j] = sgA[z]; segH[(z * 8 + tg) * 64 + j] = sgH[z]; }
          __syncthreads();
          const int tile = r0 >> 6;
#pragma unroll
          for (int z = 0; z < 2; ++z) {
              float carry = 0.f, pre = 1.f;
              if (z == 0) { for (int sI = 0; sI < tg; ++sI) { const float a = segA[(sI) * 64 + j]; carry = a * carry + segH[(sI) * 64 + j]; pre *= a; } }
              else { for (int sI = 7; sI > tg; --sI) { const float a = segA[(8 + sI) * 64 + j]; carry = a * carry + segH[(8 + sI) * 64 + j]; pre *= a; } }
#pragma unroll
              for (int t = 0; t < 8; ++t) { const int row = r0 + tg * 8 + t;
                  WSP(bf16, WS_LA)[(size_t)row * 1024 + z * 512 + c] = (bf16)f2bf(hl[z][t] + cd[z][t] * carry); WSP(bf16, WS_U)[(size_t)row * 1024 + z * 512 + c] = (bf16)f2bf(cd[z][t] * pre); }
              if (tg == (z ? 0 : 7)) { WSP(float, WS_TA)[((size_t)tile * 2 + z) * 512 + c] = pre * sgA[z]; WSP(float, WS_TH)[((size_t)tile * 2 + z) * 512 + c] = sgA[z] * carry + sgH[z]; }
          }
      }
      __syncthreads(); }
}

__device__ __forceinline__ void rglru_scan(Frame& F, int sw) {
    const int b = sw >> 1, z = sw & 1, c = F.tid;
    const float* TA = WSP(float, WS_TA) + z * 512 + c; const float* TH = WSP(float, WS_TH) + z * 512 + c; float* CR = WSP(float, WS_CARRY) + z * 512 + c;
    float carry = 0.f;
    for (int k0 = 0; k0 < 132; k0 += 12) {
        float a[12], hh[12]; int tl[12];
#pragma unroll
        for (int k = 0; k < 12; ++k) { const int kk = k0 + k; const int tile = kk < 4 ? 512 + b * 4 + (z ? 3 - kk : kk) : b * 128 + (z ? 127 - (kk - 4) : (kk - 4)); tl[k] = tile; a[k] = TA[(size_t)tile * 1024]; hh[k] = TH[(size_t)tile * 1024]; }
#pragma unroll
        for (int k = 0; k < 12; ++k) { CR[(size_t)tl[k] * 1024] = carry; carry = a[k] * carry + hh[k]; }
    }
}
template <bool V> struct BoolC { static constexpr bool v = V; };
constexpr int ATT_UL = NB * (SEQ / 32), ATT_UC = NB * (CTXL / 32);
constexpr int AT_K = 0, AT_V = 9216, AT_BUF = 18432;
__device__ __forceinline__ void attn_unit(Frame& F, int l, int u) {
    const int jl = l >> 1; const int tid = F.tid, lane = F.lane, hh = F.wave, kvh = hh >> 2, qn = lane & 15, qd = lane >> 4;
    const bf16* P = WSP(bf16, WS_P);
    LAS unsigned char* L = F.lds;
    const bool isctx = u >= ATT_UL;
    int b, t0, qrow0;
    if (!isctx) { b = u >> 8; t0 = (u & 255) * 32; qrow0 = b * SEQ + t0; } else { const int v = u - ATT_UL; b = v >> 3; t0 = (v & 7) * 32; qrow0 = NLAT + b * CTXL + t0; }
    const float L2E = 1.4426950408889634f;
    bf16x8 qf[2][2];
#pragma unroll
    for (int qt = 0; qt < 2; ++qt)
#pragma unroll
        for (int ks = 0; ks < 2; ++ks) qf[qt][ks] = *(const bf16x8*)(P + (size_t)(qrow0 + 16 * qt + qn) * PO + hh * 64 + ks * 32 + qd * 8);
    const float sink = INP(19)[jl * 8 + hh] * L2E;
    float m[2] = {sink, sink}, lsum[2]; lsum[0] = (qd == 0) ? 1.f : 0.f; lsum[1] = lsum[0];
    f32x4 oacc[2][4];
#pragma unroll
    for (int qt = 0; qt < 2; ++qt)
#pragma unroll
        for (int dt = 0; dt < 4; ++dt) oacc[qt][dt] = (f32x4){0.f, 0.f, 0.f, 0.f};
    int klo[2], khi[2];
#pragma unroll
    for (int qt = 0; qt < 2; ++qt) { const int t = t0 + 16 * qt + qn; klo[qt] = t - 128 < 0 ? 0 : t - 128; khi[qt] = t + 128 > SEQ - 1 ? SEQ - 1 : t + 128; }
    const int ngl = isctx ? 0 : 9, ng = ngl + 8;
    const int skv = tid >> 8, skey = (tid >> 3) & 31, sc8 = tid & 7;
    v4u rk, rv;
    auto gload = [&](int g) {
        const bool lat = g < ngl; const int s0 = lat ? (t0 - 128 + g * 32) : (g - ngl) * 32;
        const int s = s0 + skey; const int scl = s < 0 ? 0 : (s > SEQ - 1 ? SEQ - 1 : s);
        const int kr = lat ? (b * SEQ + scl) : (NLAT + b * CTXL + s);
        const bf16* kp = P + (size_t)kr * PO + 512 + skv * 64 + sc8 * 8; rk = *(const v4u*)kp; rv = *(const v4u*)(kp + 128);
    };
    auto lstore = [&](int buf) { LAS unsigned char* d = L + buf * AT_BUF + (skv * 32 + skey) * 144 + sc8 * 16; *(LAS v4u*)(d + AT_K) = rk; *(LAS v4u*)(d + AT_V) = rv; };
    auto gcomp = [&](int g, int buf, auto maskc) {
        constexpr bool MASKED = decltype(maskc)::v;
        const bool lat = g < ngl; const int s0 = lat ? (t0 - 128 + g * 32) : (g - ngl) * 32;
        const LAS unsigned char* kb = L + buf * AT_BUF + AT_K + kvh * (32 * 144); const LAS unsigned char* vb = L + buf * AT_BUF + AT_V + kvh * (32 * 144);
        bf16x8 kf[2][2], vf[4];
#pragma unroll
        for (int T = 0; T < 2; ++T)
#pragma unroll
            for (int ks = 0; ks < 2; ++ks) kf[T][ks] = *(const LAS bf16x8*)(kb + (16 * T + qn) * 144 + (32 * ks + 8 * qd) * 2);
        { const int qp = qn >> 2, pp = qn & 3;
#pragma unroll
          for (int dt = 0; dt < 4; ++dt) { const LAS unsigned char* a = vb + (4 * qd + qp) * 144 + (16 * dt + 4 * pp) * 2;
              const s16x4 lo = __builtin_bit_cast(s16x4, __builtin_amdgcn_ds_read_tr16_b64_v4i16((LAS s16x4*)a));
              const s16x4 hi = __builtin_bit_cast(s16x4, __builtin_amdgcn_ds_read_tr16_b64_v4i16((LAS s16x4*)(a + 16 * 144)));
              vf[dt] = (bf16x8){lo[0], lo[1], lo[2], lo[3], hi[0], hi[1], hi[2], hi[3]}; } }
#pragma unroll
        for (int qt = 0; qt < 2; ++qt) {
            f32x4 sc[2];
#pragma unroll
            for (int T = 0; T < 2; ++T) { f32x4 a = (f32x4){0.f, 0.f, 0.f, 0.f}; a = MFMA16(kf[T][0], qf[qt][0], a); a = MFMA16(kf[T][1], qf[qt][1], a); sc[T] = a; }
            float mx = -3.0e38f;
#pragma unroll
            for (int T = 0; T < 2; ++T)
#pragma unroll
                for (int r = 0; r < 4; ++r) { if constexpr (MASKED) { const int s = s0 + 16 * T + 4 * qd + r; const bool ok = (s >= klo[qt]) & (s <= khi[qt]); sc[T][r] = ok ? sc[T][r] : -3.0e38f; }
                    mx = fmaxf(mx, sc[T][r]); }
            if (!__all(mx - m[qt] <= 8.f)) {
                mx = fmaxf(mx, __shfl_xor(mx, 16)); mx = fmaxf(mx, __shfl_xor(mx, 32));
                const float mn = fmaxf(m[qt], mx), alpha = __builtin_amdgcn_exp2f(m[qt] - mn); m[qt] = mn; lsum[qt] *= alpha;
#pragma unroll
                for (int dt = 0; dt < 4; ++dt) oacc[qt][dt] *= alpha;
            }
            const float mn = m[qt];
            float p[8]; float ps = 0.f;
#pragma unroll
            for (int T = 0; T < 2; ++T)
#pragma unroll
                for (int r = 0; r < 4; ++r) { const float e = __builtin_amdgcn_exp2f(sc[T][r] - mn); p[4 * T + r] = e; ps += e; }
            lsum[qt] += ps;
            const bf16x8 pf = __builtin_bit_cast(bf16x8, pack8(p));
#pragma unroll
            for (int dt = 0; dt < 4; ++dt) oacc[qt][dt] = MFMA16(vf[dt], pf, oacc[qt][dt]);
        }
    };
    __syncthreads();
    gload(0); lstore(0);
    __syncthreads();
    for (int g = 0; g < ng; ++g) {
        if (g + 1 < ng) gload(g + 1);
        { const int s0g = t0 - 128 + g * 32; const bool need = g < ngl && (g == 0 || g == ngl - 1 || s0g < 0 || s0g + 31 > SEQ - 1);
          if (need) gcomp(g, g & 1, BoolC<true>{}); else gcomp(g, g & 1, BoolC<false>{}); }
        if (g + 1 < ng) lstore((g + 1) & 1);
        __syncthreads();
    }
#pragma unroll
    for (int qt = 0; qt < 2; ++qt) {
        float ls = lsum[qt]; ls += __shfl_xor(ls, 16); ls += __shfl_xor(ls, 32);
        const float inv = 1.f / ls;
        bf16* op = WSP(bf16, WS_HN) + (size_t)(qrow0 + 16 * qt + qn) * 1024 + hh * 64 + 4 * qd;
#pragma unroll
        for (int dt = 0; dt < 4; ++dt) { v2u o; o.x = pk2(oacc[qt][dt][0] * inv, oacc[qt][dt][1] * inv); o.y = pk2(oacc[qt][dt][2] * inv, oacc[qt][dt][3] * inv); *(v2u*)(op + dt * 16) = o; }
    }
}
__device__ __forceinline__ void phase_odd_mix(Frame& F_, int l) {
    Frame F = F_; asm volatile("" : "+v"(F.tid)); F.lane = F.tid & 63;
    const int nunits = ATT_UL + ((l == DEPTH - 1) ? 0 : ATT_UC);
    if (F.G >= 16) {
        if (F.wg < 8) { rglru_scan(F, F.wg); return; }
        for (int u = F.wg - 8; u < nunits; u += F.G - 8) attn_unit(F, l, u);
    } else {
        for (int sw = F.wg; sw < 8; sw += F.G) rglru_scan(F, sw);
        for (int u = F.wg; u < nunits; u += F.G) attn_unit(F, l, u);
    }
}
__device__ __attribute__((noinline)) void phase_odd_gate(Frame F, int l) {
    const int gw = F.wg * NWAVES + F.wave, NGW = F.G * NWAVES;
    const int nrows = (l == DEPTH - 1) ? NLAT : ROWS;
    const bf16* HL = WSP(bf16, WS_LA); const bf16* DC = WSP(bf16, WS_U); const float* CR = WSP(float, WS_CARRY); const bf16* P = WSP(bf16, WS_P);
    for (int row = gw; row < nrows; row += NGW) {
        const int ch = F.lane * 8; const int tile = row >> 6; float a[8], g[8];
#pragma unroll
        for (int k = 0; k < 8; ++k) a[k] = 0.f;
#pragma unroll
        for (int z = 0; z < 2; ++z) { float hl[8], dc[8]; unpack8(*(const v4u*)(HL + (size_t)row * 1024 + z * 512 + ch), hl); unpack8(*(const v4u*)(DC + (size_t)row * 1024 + z * 512 + ch), dc);
            const f32x4 c0 = *(const f32x4*)(CR + ((size_t)tile * 2 + z) * 512 + ch), c1 = *(const f32x4*)(CR + ((size_t)tile * 2 + z) * 512 + ch + 4);
#pragma unroll
            for (int k = 0; k < 8; ++k) a[k] += hl[k] + dc[k] * (k < 4 ? c0[k] : c1[k - 4]); }
        unpack8(*(const v4u*)(P + (size_t)row * PO + 1280 + ch), g);
#pragma unroll
        for (int k = 0; k < 8; ++k) { const float x = g[k]; const float tt = 0.7978845608028654f * (x + 0.044715f * x * x * x); const float th = 1.f - 2.f * __builtin_amdgcn_rcpf(1.f + __expf(2.f * tt));
            a[k] = a[k] * 0.5f * x * (1.f + th); }
        *(v4u*)(WSP(bf16, WS_HN) + (size_t)row * 1024 + 512 + ch) = pack8(a);
    }
}

__device__ __forceinline__ void phase_topk(Frame& F_, int l) {
    Frame F = F_; asm volatile("" : "+v"(F.tid)); F.lane = F.tid & 63;
    LAS unsigned* keys = (LAS unsigned*)F.lds;
    LAS unsigned* hist = (LAS unsigned*)(F.lds + 32768);
    LAS unsigned* sel = (LAS unsigned*)(F.lds + 32768 + 1024);
    LAS unsigned* wsum = (LAS unsigned*)(F.lds + 32768 + 1024 + 64);
    const int nprob = (l == DEPTH - 1) ? 64 : 128;
    const float* AFF = WSP(float, WS_AFF);
    for (int p = F.wg; p < nprob; p += F.G) {
        const bool isctx = p >= 64; const int b = (p & 63) >> 4, e = p & 15;
        const int n = isctx ? CTXL : SEQ, cap = isctx ? CAP_C : CAP_L, rowbase = isctx ? NLAT + b * CTXL : b * SEQ;
        const int slotbase = isctx ? NSLOT_L + e * 256 + b * CAP_C : (e * 4 + b) * CAP_L;
        __syncthreads();
        { const float* src = isctx ? AFF + (size_t)NB * 16 * SEQ + (size_t)(b * 16 + e) * CTXL : AFF + (size_t)(b * 16 + e) * SEQ;
          for (int i = F.tid; i < n; i += NTHR) keys[i] = __builtin_bit_cast(unsigned, src[i]); }
        unsigned prefix = 0u, need = (unsigned)cap;
        for (int pass = 3; pass >= 0; --pass) {
            const int shift = pass * 8;
            if (F.tid < 256) hist[F.tid] = 0u;
            __syncthreads();
            for (int i = F.tid; i < n; i += NTHR) { const unsigned k = keys[i]; const bool in = (pass == 3) || ((k >> (shift + 8)) == (prefix >> (shift + 8))); if (in) atomicAdd((unsigned*)&hist[(k >> shift) & 255u], 1u); }
            __syncthreads();
            if (F.wave == 0) {
                unsigned c[4], s = 0u;
#pragma unroll
                for (int j = 0; j < 4; ++j) { c[j] = hist[255 - (4 * F.lane + j)]; s += c[j]; }
                unsigned inc = s;
#pragma unroll
                for (int o = 1; o < 64; o <<= 1) { const unsigned t = __shfl_up(inc, o); if (F.lane >= o) inc += t; }
                const unsigned long long m = __ballot(inc >= need);
                const int Ls = __builtin_ctzll(m);
                if (F.lane == Ls) { unsigned cum = inc - s, d = 0u, nn = need; bool done = false;
#pragma unroll
                    for (int j = 0; j < 4; ++j) { if (!done && cum + c[j] >= need) { d = 255u - (unsigned)(4 * F.lane + j); nn = need - cum; done = true; } cum += c[j]; }
                    sel[0] = d; sel[1] = nn; } }
            __syncthreads();
            prefix |= sel[0] << shift; need = sel[1];
        }
        const unsigned T = prefix;
        const int ept = isctx ? 1 : 16; const int i0 = F.tid * ept;
        unsigned gt = 0u, eq = 0u;
        if (i0 < n) for (int i = 0; i < ept; ++i) { const unsigned k = keys[i0 + i]; gt += (k > T); eq += (k == T); }
        unsigned pk = gt | (eq << 16), incl = pk;
#pragma unroll
        for (int o = 1; o < 64; o <<= 1) { const unsigned t = __shfl_up(incl, o); if (F.lane >= o) incl += t; }
        if (F.lane == 63) wsum[F.wave] = incl;
        __syncthreads();
        unsigned wpre = 0u;
        for (int w = 0; w < F.wave; ++w) wpre += wsum[w];
        unsigned excl = wpre + incl - pk; unsigned gtb = excl & 0xffffu, eqb = excl >> 16;
        if (i0 < n) for (int i = 0; i < ept; ++i) { const unsigned k = keys[i0 + i]; int c = -1;
            if (k > T) { c = (int)(gtb + (eqb < need ? eqb : need)); ++gtb; }
            else if (k == T) { if (eqb < need) c = (int)(gtb + eqb); ++eqb; }
            const int row = rowbase + i0 + i;
            WSP(int, WS_INV)[(size_t)row * 16 + e] = c;
            if (c >= 0) { WSP(int, WS_IDX)[slotbase + c] = row; WSP(float, WS_GATES)[slotbase + c] = __builtin_bit_cast(float, k); } }
    }
    __syncthreads();
}
__device__ __attribute__((noinline)) void phase_gather(Frame F, int l) {
    const int gw = F.wg * NWAVES + F.wave, NGW = F.G * NWAVES;
    const int nslot = (l == DEPTH - 1) ? NSLOT_L : NSLOT_ALL;
    const int* IDX = WSP(int, WS_IDX); const bf16* HN = WSP(bf16, WS_HN); bf16* XS = WSP(bf16, WS_XS);
    for (int s = gw; s < nslot; s += NGW) {
        if (s >= NSLOT_L && ((s - NSLOT_L) & 255) >= 128) continue;
        const int row = IDX[s];
        const v4u a = *(const v4u*)(HN + (size_t)row * 1024 + F.lane * 8), c = *(const v4u*)(HN + (size_t)row * 1024 + 512 + F.lane * 8);
        *(v4u*)(XS + (size_t)s * 1024 + F.lane * 8) = a; *(v4u*)(XS + (size_t)s * 1024 + 512 + F.lane * 8) = c;
    }
}

constexpr int PPL = 12, NPH = 2 + DEPTH * PPL;
struct Args { const float* in[31]; float* out; unsigned char* ws; int ph_lo, ph_hi; };
__global__ void __launch_bounds__(NTHR, 2) mk_fwd(Args args) {
    extern __shared__ __attribute__((aligned(16))) unsigned char lds[];
    Frame F;
    F.lds = (LAS unsigned char*)lds;
    F.tid = threadIdx.x; F.lane = F.tid & 63; F.wave = __builtin_amdgcn_readfirstlane(F.tid >> 6);
    F.G = gridDim.x; F.wg = blockIdx.x;
    F.out = args.out; F.ws = args.ws;
    const int lo = args.ph_lo, hi = args.ph_hi;
    volatile LAS unsigned* MISC = (volatile LAS unsigned*)(F.lds + MISC_OFF);
    if (F.tid < 32) MISC[F.tid] = 0u;
    if (F.tid == 0) {
#pragma unroll
        for (int i = 0; i < 31; ++i) ((const float* LAS*)(F.lds + PTR_OFF))[i] = args.in[i];
    }
    __syncthreads();
    unsigned* barw = (unsigned*)(F.ws + WS_CTL) + CW_BAR;
    XcdBarrier bar; bar.bar = barw; bar.x = 0; bar.st = nullptr;
    if (hi - lo > 1) bar = xcd_barrier_post(barw, MISC + 8);
#ifndef PH_SUB
#define PH_SUB -1
#endif
#ifndef PH_ONLY
#define PH_ONLY -1
#endif
#define KIND(k) ((k) == 0 ? 0 : ((k) == NPH - 1 ? 13 : 1 + ((k) - 1) % PPL))
#define IN(k) ((PH_ONLY < 0 || PH_ONLY == KIND(k)) && lo <= (k) && (k) < hi)
#define NREP(kind, sub) ((REPK == (kind) && (kind) != 2 && (kind) != 7 && (kind) != 11 && (kind) != 12 && (REPS < 0 || REPS == (sub))) ? 2 : 1)
#define SEAM(k) do { if (IN(k) && IN((k) + 1)) xcd_barrier(bar); } while (0)
    if (IN(0)) { phase_mod(F); }
    SEAM(0);
    for (int l = 0; l < DEPTH; ++l) {
        const int pb = 1 + l * PPL; const bool even = !(l & 1), last = (l == DEPTH - 1);
        if (IN(pb + 0)) { if (l == 0) phase_weights(F, 0, 0, witems_w2(0) - 8192, 0); phase_rp1(F, l); }
        SEAM(pb + 0);
        if (IN(pb + 1)) { const int N = even ? PE : PO;
            pg8::Gemm g{WSP(pg8::bf16_t, WS_HN), WSP(pg8::bf16_t, WS_WIN), ROWS, N, DM, 0}; pg8::StaticOrder S; S.init(ROWS, N, F.G, F.wg);
            if (even) { pg8::EpiEvenIn E{WSP(pg8::bf16_t, WS_P), WSP(pg8::bf16_t, WS_ODIR), WSP(pg8::bf16_t, WS_HQ), WSP(pg8::bf16_t, WS_HK), WSP(pg8::bf16_t, WS_IB), WSP(float, WS_GB), WSP(float, WS_OMT) + (l >> 1) * 1024, INP(12) + (l >> 1) * 8, INP(13) + (l >> 1) * 8};
                pg8::gemm_phase<pg8::EpiEvenIn, pg8::StaticOrder, true, true>(F.lds, g, S, E); }
            else { pg8::EpiStoreBf16 E{WSP(pg8::bf16_t, WS_P), N, nullptr};
                pg8::gemm_phase<pg8::EpiStoreBf16, pg8::StaticOrder, true, true>(F.lds, g, S, E); }
            if (last && l > 0) phase_weights(F, l, witems_w2(l), witems_w2(l) + 4096, S.nwg % F.G);
            if (l == 0) phase_weights(F, 0, witems_w2(0) - 8192, witems_w2(0) - 8192 + 944, S.nwg % F.G); }
#if REPK == 2
        if (IN(pb + 1)) { const int N = even ? PE : PO;
            pg8::Gemm g{WSP(pg8::bf16_t, WS_HN), WSP(pg8::bf16_t, WS_WIN), ROWS, N, DM, 0}; pg8::StaticOrder S; S.init(ROWS, N, F.G, F.wg);
            if (even) { pg8::EpiEvenIn E{WSP(pg8::bf16_t, WS_P), WSP(pg8::bf16_t, WS_ODIR), WSP(pg8::bf16_t, WS_HQ), WSP(pg8::bf16_t, WS_HK), WSP(pg8::bf16_t, WS_IB), WSP(float, WS_GB), WSP(float, WS_OMT) + (l >> 1) * 1024, INP(12) + (l >> 1) * 8, INP(13) + (l >> 1) * 8};
                pg8::gemm_phase<pg8::EpiEvenIn, pg8::StaticOrder, true, true>(F.lds, g, S, E); }
            else { pg8::EpiStoreBf16 E{WSP(pg8::bf16_t, WS_P), N, nullptr};
                pg8::gemm_phase<pg8::EpiStoreBf16, pg8::StaticOrder, true, true>(F.lds, g, S, E); } }
#endif
        SEAM(pb + 1);
        if (IN(pb + 2)) { if (even) { if (PH_SUB != 1) for (int rp = 0; rp < NREP(3, 0); ++rp) { phase_even_prep(F, l); } } else { if (PH_SUB != 0) { phase_odd_prep(F, l); for (int rp = 0; rp < NREP(3, 1); ++rp) phase_odd_prep_bc(F, l); } } }
        SEAM(pb + 2);
        if (IN(pb + 3)) { if (even) { for (int rp = 0; rp < NREP(4, 0); ++rp) phase_even_chunk_d(F); for (int rp = 0; rp < NREP(4, 1); ++rp) phase_even_chunk_h(F); } }
        if (even) SEAM(pb + 3);
        if (IN(pb + 4)) { if (even) { if (PH_SUB != 1) for (int rp = 0; rp < NREP(5, 0); ++rp) { for (int r2 = 0; r2 < NREP(5, 2); ++r2) phase_even_scan_d(F); for (int r3 = 0; r3 < NREP(5, 3); ++r3) phase_even_scan_h(F); } } else { if (PH_SUB != 0) for (int rp = 0; rp < NREP(5, 1); ++rp) phase_odd_mix(F, l); } }
        SEAM(pb + 4);
        if (IN(pb + 5)) for (int rp = 0; rp < NREP(6, -1); ++rp) { if (even) phase_even_gate(F, l); else phase_odd_gate(F, l); }
        SEAM(pb + 5);
        if (IN(pb + 6)) { const int M = last ? NLAT : ROWS;
            pg8::Gemm g{WSP(pg8::bf16_t, WS_HN), WSP(pg8::bf16_t, WS_WOUT), M, DM, DM, 0}; pg8::StaticOrder S; S.init(M, DM, F.G, F.wg);
            pg8::EpiResid E{l == 0 ? INP(0) : nullptr, INP(2), WSP(pg8::bf16_t, WS_X), WSP(float, WS_MOD) + (size_t)l * 5 * 6144 + 2048};
            pg8::gemm_phase<pg8::EpiResid, pg8::StaticOrder, true, true>(F.lds, g, S, E);
            if (l > 0 && !last) phase_weights(F, l, witems_w2(l) - 3072, witems_w2(l), S.nwg % F.G);
            if (l == 0) phase_weights(F, 0, witems_w2(0) - 8192 + 944, witems_w2(0), S.nwg % F.G); }
        SEAM(pb + 6);
        if (IN(pb + 7)) for (int rp = 0; rp < NREP(8, -1); ++rp) { phase_rp2(F, l); }
        SEAM(pb + 7);
        if (IN(pb + 8)) for (int rp = 0; rp < NREP(9, -1); ++rp) { phase_topk(F, l); }
        SEAM(pb + 8);
        if (IN(pb + 9)) for (int rp = 0; rp < NREP(10, -1); ++rp) {   }
        if (IN(pb + 10)) for (int rp = 0; rp < NREP(11, -1); ++rp) { const int M = last ? NSLOT_L : NSLOT_ALL;
            pg8::Gemm g{WSP(pg8::bf16_t, WS_HN), WSP(pg8::bf16_t, WS_W13), M, 2048, DM, (size_t)2048 * 1024 * 2, WSP(int, WS_IDX), ROWS}; pg8::StaticOrder S; S.init(M, 2048, F.G, F.wg);
            pg8::EpiSwiGLU E{WSP(pg8::bf16_t, WS_HID)};
            pg8::gemm_phase<pg8::EpiSwiGLU, pg8::StaticOrder, true, true, true>(F.lds, g, S, E);
            if (!last) phase_weights(F, l, witems_w2(l), witems_w2(l) + 4096, S.nwg % F.G); }
#if REPK == 11
        if (IN(pb + 10)) { const int M = last ? NSLOT_L : NSLOT_ALL;
            pg8::Gemm g{WSP(pg8::bf16_t, WS_HN), WSP(pg8::bf16_t, WS_W13), M, 2048, DM, (size_t)2048 * 1024 * 2, WSP(int, WS_IDX), ROWS}; pg8::StaticOrder S; S.init(M, 2048, F.G, F.wg);
            pg8::EpiSwiGLU E{WSP(pg8::bf16_t, WS_HID)};
            pg8::gemm_phase<pg8::EpiSwiGLU, pg8::StaticOrder, true, true, true>(F.lds, g, S, E); }
#endif
        SEAM(pb + 10);
        if (IN(pb + 11)) for (int rp = 0; rp < NREP(12, -1); ++rp) { const int M = last ? NSLOT_L : NSLOT_ALL;
#if REPK == 13
            pg8::Gemm g{WSP(pg8::bf16_t, WS_HID), WSP(pg8::bf16_t, WS_W2), M, DM, FF, (size_t)1024 * 1024 * 2, nullptr, 0, 1}; pg8::StaticOrder S; S.init(M, DM, F.G, F.wg);
            pg8::EpiStoreBf16 E{WSP(pg8::bf16_t, WS_Y2), 1024, nullptr, 0.5f};
#elif REPK == 14
            pg8::Gemm g{WSP(pg8::bf16_t, WS_HID), WSP(pg8::bf16_t, WS_W2), M, DM, FF, (size_t)1024 * 1024 * 2, nullptr, 0, 1}; pg8::StaticOrder S; S.init(M, DM, F.G, F.wg);
            pg8::EpiStoreBf16 E{WSP(pg8::bf16_t, WS_Y2), 1024, nullptr};
#else
            pg8::Gemm g{WSP(pg8::bf16_t, WS_HID), WSP(pg8::bf16_t, WS_W2), M, DM, FF, (size_t)1024 * 1024 * 2}; pg8::StaticOrder S; S.init(M, DM, F.G, F.wg);
            pg8::EpiStoreBf16 E{WSP(pg8::bf16_t, WS_Y2), 1024, nullptr};
#endif
            pg8::gemm_phase<pg8::EpiStoreBf16, pg8::StaticOrder, true, true>(F.lds, g, S, E);
            if (!last) phase_weights(F, l + 1, 0, witems_w2(l + 1) - (l + 1 < DEPTH - 1 ? 3072 : 0), S.nwg % F.G); }
#if REPK == 12
        if (IN(pb + 11)) { const int M = last ? NSLOT_L : NSLOT_ALL;
            pg8::Gemm g{WSP(pg8::bf16_t, WS_HID), WSP(pg8::bf16_t, WS_W2), M, DM, FF, (size_t)1024 * 1024 * 2}; pg8::StaticOrder S; S.init(M, DM, F.G, F.wg);
            pg8::EpiStoreBf16 E{WSP(pg8::bf16_t, WS_Y2), 1024, nullptr};
            pg8::gemm_phase<pg8::EpiStoreBf16, pg8::StaticOrder, true, true>(F.lds, g, S, E); }
#endif
        SEAM(pb + 11);
    }
    if (IN(NPH - 1)) phase_final(F);
#undef IN
#undef SEAM
}

extern "C" void kernel_launch(void* const* d_in, const int* in_sizes, int n_in, void* d_out, int out_size, void* d_ws, size_t ws_size, hipStream_t stream) {
    static int grid = 0;
    if (grid == 0) {
        if (n_in != 31 || in_sizes[0] != NLAT * DM || out_size != NLAT * DM || ws_size < WS_END) { fprintf(stderr, "kernel_launch: unexpected shapes / workspace (n_in %d, ws %zu); nothing launched\n", n_in, ws_size); grid = -1; return; }
        int dev = 0, cus = 0, per_cu = 0;
        if (hipGetDevice(&dev) != hipSuccess || hipDeviceGetAttribute(&cus, hipDeviceAttributeMultiprocessorCount, dev) != hipSuccess) { grid = -1; return; }
        if (hipFuncSetAttribute((const void*)mk_fwd, hipFuncAttributeMaxDynamicSharedMemorySize, LDS_BYTES) != hipSuccess) { fprintf(stderr, "kernel_launch: hipFuncSetAttribute failed\n"); grid = -1; return; }
        if (hipOccupancyMaxActiveBlocksPerMultiprocessor(&per_cu, (const void*)mk_fwd, NTHR, LDS_BYTES) != hipSuccess || per_cu < 1) { fprintf(stderr, "kernel_launch: occupancy query says %d\n", per_cu); }
        (void)hipGetLastError();
        grid = cus;
    }
    if (grid < 0) return;
    (void)hipMemsetAsync((char*)d_ws + WS_CTL, 0, CTL_ZERO_BYTES, stream);
    Args a{};
    for (int i = 0; i < 31; ++i) a.in[i] = (const float*)d_in[i];
    a.out = (float*)d_out; a.ws = (unsigned char*)d_ws;
#if MK_ONE_LAUNCH
    a.ph_lo = 0; a.ph_hi = NPH;
    hipLaunchKernelGGL(mk_fwd, dim3(grid), dim3(NTHR), LDS_BYTES, stream, a);
#else
    for (int k = 0; k < NPH; ++k) { a.ph_lo = k; a.ph_hi = k + 1; hipLaunchKernelGGL(mk_fwd, dim3(grid), dim3(NTHR), LDS_BYTES, stream, a); }
#endif
}
```

```cpp
#include <hip/hip_runtime.h>
#include <cstdio>
#include <cstdint>

#define REPK -1
#define REPS -1
#ifndef MK_ONE_LAUNCH
#define MK_ONE_LAUNCH 1
#endif

namespace pg8 {
#define PG8_LAS __attribute__((address_space(3)))
typedef unsigned short bf16_t;
typedef short bf16x8 __attribute__((ext_vector_type(8)));
typedef float f32x4 __attribute__((ext_vector_type(4)));
typedef unsigned u32x4 __attribute__((ext_vector_type(4)));
constexpr int BM = 256, BK = 64, HALF = 128, HTB = HALF * BK * 2  , STAGE_BYTES = 8 * HTB, NXCD = 8, WGM = 8;

__host__ __device__ __forceinline__ int lds_byte(int r, int c) { const int st = (r >> 4) * 2 + (c >> 5), rr = r & 15, cc = c & 31, ob = rr * 64 + cc * 2; return st * 1024 + (ob ^ (((ob >> 9) & 1) << 5)); }
__host__ __device__ __forceinline__ void stage_rc(int b, int& R, int& C) { const int st = b / 1024, sb = b % 1024, swz = sb ^ (((sb >> 9) & 1) << 5); R = (st >> 1) * 16 + swz / 64; C = (st & 1) * 32 + (swz % 64) / 2; }
__host__ __device__ __forceinline__ int perm32(int rho) { const int n = rho >> 4, i = rho & 15; return 8 * (i >> 2) + 4 * n + (i & 3); }

struct Unit { int pm, pn; };
struct Gemm { const bf16_t* A; const bf16_t* Bt; int M, N, K; size_t gstride; const int* gidx; int grows; int krep; };
__device__ __forceinline__ size_t bgroup(int pm) { return (size_t)(pm < 256 ? (pm >> 4) : (pm - 256)); }

struct StaticOrder {
    int nM, nN, nwg, G, c;
    __host__ __device__ void init(int M, int N, int G_, int c_) { nM = M / BM; nN = N / BM; nwg = nM * nN; G = G_; c = c_; }
    __host__ __device__ bool next(int i, Unit& u) const {
        const long L = (long)i * G + c; if (L >= nwg) return false;
        int wgid = (int)L; { const int q = nwg / NXCD, r = nwg % NXCD, xcd = wgid % NXCD, off = wgid / NXCD; wgid = (xcd < r ? xcd * (q + 1) : r * (q + 1) + (xcd - r) * q) + off; }
        const int nig = WGM * nN, gid = wgid / nig, fm = gid * WGM, gsz = (nM - fm) < WGM ? (nM - fm) : WGM;
        u.pm = fm + ((wgid % nig) % gsz); u.pn = (wgid % nig) / gsz; return true;
    }
    __device__ __forceinline__ void a_ready(const Unit&) const {}
    __device__ __forceinline__ void done(const Unit&) const {}
};

__device__ __forceinline__ unsigned cvt_pk_bf16(float lo, float hi) { unsigned r; asm volatile("v_cvt_pk_bf16_f32 %0, %1, %2" : "=v"(r) : "v"(lo), "v"(hi)); return r; }

struct EpiStoreBf16 {
    static constexpr bool PERM = true, AFTER_DRAIN = false;
    bf16_t* O; int ldc; const float* rowscale; float mul;
    __device__ __forceinline__ void operator()(const f32x4 (&acc)[2][2][4][2], const Unit& u, int wr, int wc, int fr, int fq) const {
        const int row0 = u.pm * BM + wr * 64 + fr, col0 = u.pn * BM + wc * 32 + 8 * fq;
#pragma unroll
        for (int ai = 0; ai < 2; ++ai)
#pragma unroll
            for (int m = 0; m < 4; ++m) { const int row = row0 + ai * HALF + m * 16; const float sc = (rowscale ? rowscale[row] : 1.f) * (mul != 0.f ? mul : 1.f); bf16_t* rowp = O + (size_t)row * ldc + col0;
#pragma unroll
                for (int bj = 0; bj < 2; ++bj) { const f32x4 v0 = acc[ai][bj][m][0] * sc, v1 = acc[ai][bj][m][1] * sc;
                    u32x4 w; w.x = cvt_pk_bf16(v0[0], v0[1]); w.y = cvt_pk_bf16(v0[2], v0[3]); w.z = cvt_pk_bf16(v1[0], v1[1]); w.w = cvt_pk_bf16(v1[2], v1[3]);
                    *(u32x4*)(rowp + bj * HALF) = w; } }
    }
};

struct EpiResid {
    static constexpr bool PERM = true, AFTER_DRAIN = false;
    const float* xlat; const float* xctx; bf16_t* X; const float* gate;
    __device__ __forceinline__ void operator()(const f32x4 (&acc)[2][2][4][2], const Unit& u, int wr, int wc, int fr, int fq) const {
        const int row0 = u.pm * BM + wr * 64 + fr, col0 = u.pn * BM + wc * 32 + 8 * fq;
        const float* gp = gate + (size_t)(u.pm < 128 ? (u.pm >> 5) : 4) * 6144 + col0;
        f32x4 g[2][2];
#pragma unroll
        for (int bj = 0; bj < 2; ++bj)
#pragma unroll
            for (int n = 0; n < 2; ++n) g[bj][n] = *(const f32x4*)(gp + bj * HALF + 4 * n);
#pragma unroll
        for (int ai = 0; ai < 2; ++ai)
#pragma unroll
            for (int m = 0; m < 4; ++m) { const int row = row0 + ai * HALF + m * 16; bf16_t* xo = X + (size_t)row * 1024 + col0;
#pragma unroll
                for (int bj = 0; bj < 2; ++bj) { f32x4 x0, x1;
                    if (xlat) { const float* xin = (row < 32768 ? xlat + (size_t)row * 1024 : xctx + (size_t)(row - 32768) * 1024) + col0 + bj * HALF; x0 = *(const f32x4*)xin; x1 = *(const f32x4*)(xin + 4); }
                    else { const u32x4 w = *(const u32x4*)(xo + bj * HALF);
                        x0 = (f32x4){__builtin_bit_cast(float, w.x << 16), __builtin_bit_cast(float, w.x & 0xffff0000u), __builtin_bit_cast(float, w.y << 16), __builtin_bit_cast(float, w.y & 0xffff0000u)};
                        x1 = (f32x4){__builtin_bit_cast(float, w.z << 16), __builtin_bit_cast(float, w.z & 0xffff0000u), __builtin_bit_cast(float, w.w << 16), __builtin_bit_cast(float, w.w & 0xffff0000u)}; }
                    const f32x4 o0 = x0 + g[bj][0] * acc[ai][bj][m][0], o1 = x1 + g[bj][1] * acc[ai][bj][m][1];
                    u32x4 ow; ow.x = cvt_pk_bf16(o0[0], o0[1]); ow.y = cvt_pk_bf16(o0[2], o0[3]); ow.z = cvt_pk_bf16(o1[0], o1[1]); ow.w = cvt_pk_bf16(o1[2], o1[3]);
                    *(u32x4*)(xo + bj * HALF) = ow; } }
    }
};

struct EpiSwiGLU {
    static constexpr bool PERM = true, AFTER_DRAIN = false;
    bf16_t* O;
    __device__ __forceinline__ void operator()(const f32x4 (&acc)[2][2][4][2], const Unit& u, int wr, int wc, int fr, int fq) const {
        const int row0 = u.pm * BM + wr * 64 + fr, col0 = u.pn * HALF + wc * 32 + 8 * fq;
#pragma unroll
        for (int ai = 0; ai < 2; ++ai)
#pragma unroll
            for (int m = 0; m < 4; ++m) { const int row = row0 + ai * HALF + m * 16; float h[8];
#pragma unroll
                for (int n = 0; n < 2; ++n)
#pragma unroll
                    for (int i = 0; i < 4; ++i) { const float a = acc[ai][0][m][n][i], b = acc[ai][1][m][n][i]; h[4 * n + i] = a * b * __builtin_amdgcn_rcpf(1.f + __expf(-a)); }
                u32x4 w; w.x = cvt_pk_bf16(h[0], h[1]); w.y = cvt_pk_bf16(h[2], h[3]); w.z = cvt_pk_bf16(h[4], h[5]); w.w = cvt_pk_bf16(h[6], h[7]);
                *(u32x4*)(O + (size_t)row * 1024 + col0) = w; }
    }
};


struct EpiEvenIn {
    static constexpr bool PERM = true, AFTER_DRAIN = false;
    bf16_t* P; bf16_t* GG; bf16_t* HQ; bf16_t* HK; bf16_t* IB; float* GB; const float* OM; const float* alog; const float* dtb;
    __device__ __forceinline__ void operator()(const f32x4 (&acc)[2][2][4][2], const Unit& u, int wr, int wc, int fr, int fq) const {
        const int row0 = u.pm * BM + wr * 64 + fr, pn = u.pn;
#pragma unroll
        for (int ai = 0; ai < 2; ++ai)
#pragma unroll
            for (int m = 0; m < 4; ++m) { const int row = row0 + ai * HALF + m * 16;
#pragma unroll
                for (int bj = 0; bj < 2; ++bj) { const int cc = bj * HALF + wc * 32 + 8 * fq; float x[8];
#pragma unroll
                    for (int i = 0; i < 4; ++i) { x[i] = acc[ai][bj][m][0][i]; x[4 + i] = acc[ai][bj][m][1][i]; }
                    bf16_t* dst = nullptr;
                    if (pn <= 5) dst = P + (size_t)row * 4864 + pn * 256 + cc;
                    else if (pn <= 7) dst = GG + (size_t)row * 1024 + (pn - 6) * 256 + cc;
                    else if (pn == 16 || pn == 17) dst = GG + (size_t)row * 1024 + 512 + (pn - 16) * 256 + cc;
                    else if (pn <= 9) { dst = HQ + (size_t)row * 512 + (pn - 8) * 256 + cc;
#pragma unroll
                        for (int i = 0; i < 8; ++i) x[i] = x[i] * __builtin_amdgcn_rcpf(1.f + __expf(-x[i])); }
                    else if (pn <= 11) dst = IB + (size_t)row * 512 + (pn - 10) * 256 + cc;
                    else if (pn <= 15) { const int z = (pn - 12) >> 1, c512 = ((pn - 12) & 1) * 256 + cc; dst = HK + (size_t)row * 1024 + z * 512 + c512;
                        const f32x4 o0 = *(const f32x4*)(OM + z * 512 + c512), o1 = *(const f32x4*)(OM + z * 512 + c512 + 4);
#pragma unroll
                        for (int i = 0; i < 8; ++i) x[i] = (i < 4 ? o0[i] : o1[i - 4]) * __builtin_amdgcn_rcpf(1.f + __expf(x[i])); }
                    else { if (cc == 0) { f32x4 g0, g1;
#pragma unroll
                            for (int i = 0; i < 8; ++i) { const float t = x[i] + dtb[i]; const float sp = t > 20.f ? t : log1pf(__expf(t)); const float gg = -__expf(alog[i]) * sp; if (i < 4) g0[i] = gg; else g1[i - 4] = gg; }
                            *(f32x4*)(GB + (size_t)row * 16) = g0; *(f32x4*)(GB + (size_t)row * 16 + 4) = g1; }
                        else if (cc == 8) { f32x4 g0, g1;
#pragma unroll
                            for (int i = 0; i < 8; ++i) { const float bb = __builtin_amdgcn_rcpf(1.f + __expf(-x[i])); if (i < 4) g0[i] = bb; else g1[i - 4] = bb; }
                            *(f32x4*)(GB + (size_t)row * 16 + 8) = g0; *(f32x4*)(GB + (size_t)row * 16 + 12) = g1; } }
                    if (dst) { u32x4 w; w.x = cvt_pk_bf16(x[0], x[1]); w.y = cvt_pk_bf16(x[2], x[3]); w.z = cvt_pk_bf16(x[4], x[5]); w.w = cvt_pk_bf16(x[6], x[7]); *(u32x4*)dst = w; } } }
    }
};
template <class Epi, class Sched, bool ALIGN_EPI = false, bool SP2 = false, bool GATHER = false>
__device__ __forceinline__ void gemm_phase(PG8_LAS unsigned char* lds, const Gemm g, const Sched& S, const Epi& E) {
    int tid_ = threadIdx.x; asm volatile("" : "+v"(tid_));
    const int tid = tid_, wid = __builtin_amdgcn_readfirstlane(tid >> 6), lane = tid & 63, wr = wid >> 2, wc = wid & 3, fr = lane & 15, fq = lane >> 4;
#if REPK == 13
    const int K = g.K, nt0 = K / BK, nt = nt0 * (g.krep ? 2 : 1);
#define PG8_KW(x) ((x) & (nt0 - 1))
#else
    const int K = g.K, nt = K / BK;
#define PG8_KW(x) (x)
#endif
    unsigned voffA[2], voffB[2];
#pragma unroll
    for (int i = 0; i < 2; ++i) { int R, C; stage_rc(tid * 16 + i * 8192, R, C); const int Rb = Epi::PERM ? ((R & ~31) + perm32(R & 31)) : R;
        voffA[i] = (unsigned)(R * K + C) * 2u; voffB[i] = (unsigned)(Rb * K + C) * 2u; }
    unsigned ogc[2][2], ogn[2][2];
    PG8_LAS int* gtab = (PG8_LAS int*)(lds + STAGE_BYTES + 2048);
    if constexpr (GATHER) { Unit uu;
        for (int i = 0; i < 12 && S.next(i, uu); ++i) if (tid < 256) { unsigned r = (unsigned)g.gidx[uu.pm * BM + tid]; gtab[i * 256 + tid] = (int)(r < (unsigned)g.grows ? r : (unsigned)(g.grows - 1)); }
        __syncthreads(); }
    auto gofs = [&](int ord, unsigned (&o)[2][2]) {
#pragma unroll
        for (int hh = 0; hh < 2; ++hh)
#pragma unroll
            for (int i = 0; i < 2; ++i) { int R, C; stage_rc(tid * 16 + i * 8192, R, C); const unsigned r = (unsigned)gtab[ord * 256 + hh * HALF + R];
                o[hh][i] = r * (unsigned)(K * 2) + (unsigned)(C * 2); } };
    const size_t kstep = (size_t)(BK * 2);
    const size_t hstep = (size_t)HALF * K * 2;
    const size_t tstep = 2 * hstep;
    const unsigned ldsw = (unsigned)wid * 1024u;
    const int aoff = lds_byte(wr * 64 + fr, fq * 8), boff = lds_byte(wc * 32 + fr, fq * 8);
#define PG8_SA(b, h) (((b) * 2 + (h)) * HTB)
#define PG8_SB(b, h) ((4 + (b) * 2 + (h)) * HTB)
#define PG8_STAGE(bufoff, gbase, voff) do { _Pragma("unroll") for (int _i = 0; _i < 2; ++_i) \
        __builtin_amdgcn_global_load_lds((const unsigned*)((const char*)(gbase) + (voff)[_i]), (PG8_LAS unsigned*)(lds + (bufoff) + ldsw + _i * 8192), 16, 0, 0); } while (0)
#define PG8_STAGE_A(bufoff, gbase, hh, nx) do { if constexpr (GATHER) { _Pragma("unroll") for (int _i = 0; _i < 2; ++_i) \
        __builtin_amdgcn_global_load_lds((const unsigned*)((const char*)(gbase) + ((nx) ? ogn[hh][_i] : ogc[hh][_i])), (PG8_LAS unsigned*)(lds + (bufoff) + ldsw + _i * 8192), 16, 0, 0); } \
        else { PG8_STAGE(bufoff, (gbase) + (hh) * hstep, voffA); } } while (0)
#define PG8_LDA(dst, b, h) do { _Pragma("unroll") for (int m = 0; m < 4; ++m) _Pragma("unroll") for (int k = 0; k < 2; ++k) dst[m][k] = *(const PG8_LAS bf16x8*)(lds + PG8_SA(b, h) + aoff + m * 2048 + k * 1024); } while (0)
#define PG8_LDB(dst, b, h) do { _Pragma("unroll") for (int n = 0; n < 2; ++n) _Pragma("unroll") for (int k = 0; k < 2; ++k) dst[n][k] = *(const PG8_LAS bf16x8*)(lds + PG8_SB(b, h) + boff + n * 2048 + k * 1024); } while (0)
#define PG8_MMA(ai, bj, At, Bt) do { __builtin_amdgcn_s_setprio(1); _Pragma("unroll") for (int m = 0; m < 4; ++m) _Pragma("unroll") for (int n = 0; n < 2; ++n) _Pragma("unroll") for (int k = 0; k < 2; ++k) \
        acc[ai][bj][m][n] = __builtin_amdgcn_mfma_f32_16x16x32_bf16(Bt[n][k], At[m][k], acc[ai][bj][m][n], 0, 0, 0); __builtin_amdgcn_s_setprio(0); } while (0)
#define PG8_WAIT_V(n) asm volatile("s_waitcnt vmcnt(" #n ")" ::: "memory")
#define PG8_WAIT_L(n) asm volatile("s_waitcnt lgkmcnt(" #n ")" ::: "memory")
#define PG8_BAR __builtin_amdgcn_s_barrier()
#define PG8_SCHED __builtin_amdgcn_sched_barrier(0)
    Unit cur, nxt; int ui = 0;
    if (!S.next(0, cur)) return;
    f32x4 acc[2][2][4][2];
#pragma unroll
    for (int a = 0; a < 2; ++a)
#pragma unroll
        for (int b = 0; b < 2; ++b)
#pragma unroll
            for (int m = 0; m < 4; ++m)
#pragma unroll
                for (int n = 0; n < 2; ++n) acc[a][b][m][n] = (f32x4){0.f, 0.f, 0.f, 0.f};
    bf16x8 At[4][2], B0[2][2], B1[2][2];
    const char* cA = (const char*)g.A + (GATHER ? (size_t)0 : (size_t)cur.pm * tstep); if constexpr (GATHER) gofs(0, ogc); const char* cB = (const char*)g.Bt + (g.gstride ? bgroup(cur.pm) * g.gstride : (size_t)0) + (size_t)cur.pn * tstep;
    S.a_ready(cur);
    if constexpr (SP2) {
        PG8_STAGE(PG8_SB(0, 0), cB, voffB); PG8_STAGE(PG8_SB(0, 1), cB + hstep, voffB); PG8_STAGE_A(PG8_SA(0, 0), cA, 0, false); PG8_STAGE_A(PG8_SA(0, 1), cA, 1, false);
        if (wr == 1) PG8_BAR;
        PG8_WAIT_V(2); PG8_BAR;
        PG8_STAGE(PG8_SB(1, 0), cB + kstep, voffB); PG8_STAGE_A(PG8_SA(1, 0), cA + kstep, 0, false); PG8_STAGE(PG8_SB(1, 1), cB + hstep + kstep, voffB);
        PG8_WAIT_V(6); PG8_BAR;
    } else {
        PG8_STAGE(PG8_SB(0, 0), cB, voffB); PG8_STAGE_A(PG8_SA(0, 0), cA, 0, false); PG8_STAGE(PG8_SB(0, 1), cB + hstep, voffB); PG8_STAGE_A(PG8_SA(0, 1), cA, 1, false);
        if (wr == 1) PG8_BAR;
        PG8_WAIT_V(4); PG8_BAR;
        PG8_STAGE(PG8_SB(1, 0), cB + kstep, voffB); PG8_STAGE_A(PG8_SA(1, 0), cA + kstep, 0, false); PG8_STAGE(PG8_SB(1, 1), cB + hstep + kstep, voffB);
        PG8_WAIT_V(6); PG8_BAR;
    }
    for (;;) {
        const bool has_next = S.next(ui + 1, nxt);
        const char* nA = has_next ? (const char*)g.A + (GATHER ? (size_t)0 : (size_t)nxt.pm * tstep) : cA; if constexpr (GATHER) { if (has_next) gofs(ui + 1, ogn); } const bool nxs_all = has_next; const char* nB = has_next ? (const char*)g.Bt + (g.gstride ? bgroup(nxt.pm) * g.gstride : (size_t)0) + (size_t)nxt.pn * tstep : cB;
        for (int t = 0; t < nt; t += 2) {
            const bool last = (t == nt - 2); const bool nxs = last && nxs_all;
            const char* a1 = cA + (size_t)PG8_KW(t + 1) * kstep;
            const char* a2 = last ? nA : cA + (size_t)PG8_KW(t + 2) * kstep; const char* b2 = last ? nB : cB + (size_t)PG8_KW(t + 2) * kstep;
            const char* a3 = a2 + kstep; const char* b3 = b2 + kstep;
            if (last && has_next) S.a_ready(nxt);
            if constexpr (SP2) {
            PG8_LDB(B0, 0, 0); PG8_LDB(B1, 0, 1); PG8_SCHED; PG8_LDA(At, 0, 0); PG8_STAGE_A(PG8_SA(1, 1), a1, 1, false);
            PG8_WAIT_V(8); PG8_WAIT_L(0); PG8_BAR; PG8_MMA(0, 0, At, B0); PG8_MMA(0, 1, At, B1); PG8_BAR; PG8_SCHED;
            PG8_LDA(At, 0, 1); PG8_STAGE(PG8_SB(0, 0), b2, voffB); PG8_STAGE(PG8_SB(0, 1), b2 + hstep, voffB); PG8_STAGE_A(PG8_SA(0, 0), a2, 0, nxs);
            PG8_WAIT_V(8); PG8_WAIT_L(0); PG8_BAR; PG8_MMA(1, 0, At, B0); PG8_MMA(1, 1, At, B1); PG8_BAR; PG8_SCHED;
            PG8_LDB(B0, 1, 0); PG8_LDB(B1, 1, 1); PG8_SCHED; PG8_LDA(At, 1, 0); PG8_STAGE_A(PG8_SA(0, 1), a2, 1, nxs);
            PG8_WAIT_V(8); PG8_WAIT_L(0); PG8_BAR; PG8_MMA(0, 0, At, B0); PG8_MMA(0, 1, At, B1); PG8_BAR; PG8_SCHED;
            PG8_LDA(At, 1, 1); PG8_STAGE(PG8_SB(1, 0), b3, voffB); PG8_STAGE(PG8_SB(1, 1), b3 + hstep, voffB); PG8_STAGE_A(PG8_SA(1, 0), a3, 0, nxs);
            PG8_WAIT_V(8); PG8_WAIT_L(0); PG8_BAR; PG8_MMA(1, 0, At, B0); PG8_MMA(1, 1, At, B1); PG8_BAR; PG8_SCHED;
            } else {
            PG8_LDB(B0, 0, 0); PG8_SCHED; PG8_LDA(At, 0, 0); PG8_STAGE_A(PG8_SA(1, 1), a1, 1, false);
            PG8_WAIT_L(8); PG8_BAR; PG8_WAIT_L(0); PG8_MMA(0, 0, At, B0); PG8_BAR; PG8_SCHED;
            PG8_LDB(B1, 0, 1); PG8_STAGE(PG8_SB(0, 0), b2, voffB);
            PG8_BAR; PG8_WAIT_L(0); PG8_MMA(0, 1, At, B1); PG8_BAR;
            PG8_LDA(At, 0, 1); PG8_STAGE_A(PG8_SA(0, 0), a2, 0, nxs);
            PG8_BAR; PG8_WAIT_L(0); PG8_MMA(1, 0, At, B0); PG8_BAR; PG8_SCHED;
            PG8_STAGE(PG8_SB(0, 1), b2 + hstep, voffB);
            PG8_WAIT_V(6); PG8_BAR; PG8_MMA(1, 1, At, B1); PG8_BAR;
            PG8_LDB(B0, 1, 0); PG8_SCHED; PG8_LDA(At, 1, 0); PG8_STAGE_A(PG8_SA(0, 1), a2, 1, nxs);
            PG8_WAIT_L(8); PG8_BAR; PG8_WAIT_L(0); PG8_MMA(0, 0, At, B0); PG8_BAR; PG8_SCHED;
            PG8_LDB(B1, 1, 1); PG8_STAGE(PG8_SB(1, 0), b3, voffB);
            PG8_BAR; PG8_WAIT_L(0); PG8_MMA(0, 1, At, B1); PG8_BAR;
            PG8_LDA(At, 1, 1); PG8_STAGE_A(PG8_SA(1, 0), a3, 0, nxs);
            PG8_BAR; PG8_WAIT_L(0); PG8_MMA(1, 0, At, B0); PG8_BAR; PG8_SCHED;
            PG8_STAGE(PG8_SB(1, 1), b3 + hstep, voffB);
            PG8_WAIT_V(6); PG8_BAR; PG8_MMA(1, 1, At, B1); PG8_BAR;
            }
        }
        if constexpr (ALIGN_EPI) { if (wr == 0) PG8_BAR; }
        if constexpr (!Epi::AFTER_DRAIN) { E(acc, cur, wr, wc, fr, fq); S.done(cur); }
        if (!has_next) break;
#pragma unroll
        for (int a = 0; a < 2; ++a)
#pragma unroll
            for (int b = 0; b < 2; ++b)
#pragma unroll
                for (int m = 0; m < 4; ++m)
#pragma unroll
                    for (int n = 0; n < 2; ++n) acc[a][b][m][n] = (f32x4){0.f, 0.f, 0.f, 0.f};
        cur = nxt; cA = nA; cB = nB; ++ui;
        if constexpr (GATHER) {
#pragma unroll
            for (int hh = 0; hh < 2; ++hh) { ogc[hh][0] = ogn[hh][0]; ogc[hh][1] = ogn[hh][1]; } }
        if constexpr (ALIGN_EPI) { if (wr == 1) PG8_BAR; }
    }
    PG8_WAIT_V(0);
    if constexpr (!ALIGN_EPI) { if (wr == 0) PG8_BAR; }
    PG8_BAR;
    if constexpr (Epi::AFTER_DRAIN) { E.fused(acc, cur, wr, wc, fr, fq, lds, wid, lane); S.done(cur); }
#undef PG8_KW
#undef PG8_SA
#undef PG8_SB
#undef PG8_STAGE
#undef PG8_STAGE_A
#undef PG8_LDA
#undef PG8_LDB
#undef PG8_MMA
#undef PG8_WAIT_V
#undef PG8_WAIT_L
#undef PG8_BAR
#undef PG8_SCHED
}
}

constexpr int NWAVES = 8, NTHR = 512;
constexpr int DM = 1024, NB = 4, SEQ = 8192, CTXL = 256, NLAT = NB * SEQ, NCTX = NB * CTXL, ROWS = NLAT + NCTX;
constexpr int DEPTH = 4, NE = 16, FF = 1024;
constexpr int PE = 4864;
constexpr int PO = 1792;
constexpr int CAP_L = 1024, CAP_C = 32;
constexpr int NSLOT_L = NE * NB * CAP_L  , NSLOT_ALL = NSLOT_L + NE * 256  ;
constexpr int VTLEN = 8448;
constexpr float EPS = 1e-6f;

constexpr size_t MiB = 1u << 20;
constexpr size_t WS_CTL = 0, CTL_ZERO_BYTES = 1 * MiB;
constexpr size_t WS_MOD = 1 * MiB;
constexpr size_t WS_OMT = 1 * MiB + 512 * 1024;
constexpr size_t WS_AFF = 2 * MiB;
constexpr size_t WS_INV = 5 * MiB;
constexpr size_t WS_GB = 8 * MiB;
constexpr size_t WS_IDX = 11 * MiB;
constexpr size_t WS_GATES = 12 * MiB;
constexpr size_t WS_VT = 13 * MiB;
constexpr size_t WS_WIN = 22 * MiB;
constexpr size_t WS_WOUT = 32 * MiB;
constexpr size_t WS_W13 = 34 * MiB;
constexpr size_t WS_W2 = 98 * MiB;
constexpr size_t WS_X = 130 * MiB;
constexpr size_t WS_HN = 262 * MiB;
constexpr size_t WS_P = 328 * MiB;
constexpr size_t WS_PREP = 664 * MiB;
constexpr size_t WS_ODIR = 862 * MiB;
constexpr size_t WS_IB = 994 * MiB;
constexpr size_t WS_END = 1027 * MiB;
constexpr size_t WS_XS = WS_P, WS_HID = WS_P + 136 * MiB, WS_Y2 = WS_PREP;
constexpr size_t WS_QKVN = WS_PREP, WS_HQ = WS_PREP + 99 * MiB, WS_HK = WS_PREP + 132 * MiB;
constexpr size_t WS_LA = WS_PREP, WS_U = WS_PREP + 66 * MiB;
constexpr size_t WS_TA = WS_ODIR, WS_TH = WS_ODIR + 4 * MiB, WS_CARRY = WS_ODIR + 8 * MiB;
static_assert((size_t)ROWS * PE * 2 <= 314 * MiB && (size_t)NSLOT_ALL * 1024 * 2 <= 136 * MiB && (size_t)ROWS * 1536 * 2 <= 99 * MiB && (size_t)ROWS * 1024 * 2 <= 66 * MiB, "ws map");
constexpr int CW_BAR = 4096;

constexpr int RING_BYTES = 131072, LDS_BYTES = 147456, MISC_OFF = LDS_BYTES - 1024, PTR_OFF = LDS_BYTES - 512;

#define GAS __attribute__((address_space(1)))
#define LAS __attribute__((address_space(3)))
typedef unsigned short bf16;
typedef unsigned v4u __attribute__((ext_vector_type(4)));
typedef unsigned v2u __attribute__((ext_vector_type(2)));
typedef float f32x4 __attribute__((ext_vector_type(4)));
typedef short bf16x8 __attribute__((ext_vector_type(8)));
typedef short s16x4 __attribute__((ext_vector_type(4)));
#define VM_WAIT() asm volatile("s_waitcnt vmcnt(0)" ::: "memory")
#define MFMA16(a, b, c) __builtin_amdgcn_mfma_f32_16x16x32_bf16((a), (b), (c), 0, 0, 0)

typedef float f32x2_t __attribute__((ext_vector_type(2))); typedef __bf16 bf16x2_t __attribute__((ext_vector_type(2)));
__device__ __forceinline__ unsigned pk2(float lo, float hi) { f32x2_t v = {lo, hi}; bf16x2_t b = __builtin_convertvector(v, bf16x2_t); return __builtin_bit_cast(unsigned, b); }
__device__ __forceinline__ unsigned f2bf(float f) { return pk2(f, 0.f) & 0xffffu; }
__device__ __forceinline__ float bflo(unsigned u) { return __builtin_bit_cast(float, u << 16); }
__device__ __forceinline__ float bfhi(unsigned u) { return __builtin_bit_cast(float, u & 0xffff0000u); }
__device__ __forceinline__ float bf1(bf16 u) { return __builtin_bit_cast(float, (unsigned)u << 16); }
__device__ __forceinline__ void unpack8(const v4u w, float (&f)[8]) { f[0] = bflo(w.x); f[1] = bfhi(w.x); f[2] = bflo(w.y); f[3] = bfhi(w.y); f[4] = bflo(w.z); f[5] = bfhi(w.z); f[6] = bflo(w.w); f[7] = bfhi(w.w); }
__device__ __forceinline__ v4u pack8(const float (&f)[8]) { v4u w; w.x = pk2(f[0], f[1]); w.y = pk2(f[2], f[3]); w.z = pk2(f[4], f[5]); w.w = pk2(f[6], f[7]); return w; }
__device__ __forceinline__ float sigmoidf_(float x) { return __builtin_amdgcn_rcpf(1.f + __expf(-x)); }
__device__ __forceinline__ float siluf_(float x) { return x * sigmoidf_(x); }
__device__ __forceinline__ float softplusf_(float x) { return x > 20.f ? x : log1pf(__expf(x)); }
__device__ __forceinline__ float wave_sum(float v) {
#pragma unroll
    for (int o = 1; o < 64; o <<= 1) v += __shfl_xor(v, o);
    return v;
}
__device__ __forceinline__ float dppf(float v, const int ctrl_sel) {
    const int b = __builtin_bit_cast(int, v); int r;
    if (ctrl_sel == 0) r = __builtin_amdgcn_update_dpp(0, b, 0xB1, 0xF, 0xF, true);
    else if (ctrl_sel == 1) r = __builtin_amdgcn_update_dpp(0, b, 0x4E, 0xF, 0xF, true);
    else if (ctrl_sel == 2) r = __builtin_amdgcn_update_dpp(0, b, 0x141, 0xF, 0xF, true);
    else r = __builtin_amdgcn_update_dpp(0, b, 0x140, 0xF, 0xF, true);
    return __builtin_bit_cast(float, r);
}
__device__ __forceinline__ float row16_sum(float v) {
    v += dppf(v, 0); v += dppf(v, 1); v += dppf(v, 2); v += dppf(v, 3); return v;
}

#define XB_TMO      128
#define XB_XCNT(j)  (256  + 64 * (j))
#define XB_XSUB(j)  (1280 + 64 * (j))
#define XB_XGEN(j)  (2304 + 64 * (j))
#define XB_TOP      3328
#define XB_TOPGEN   3392
#define XCD_BAR_WORDS 3456
#define XB_SPIN_CAP (1u << 22)
__device__ __forceinline__ unsigned xb_ld(unsigned* p)              { return __hip_atomic_load(p, __ATOMIC_RELAXED, __HIP_MEMORY_SCOPE_AGENT); }
__device__ __forceinline__ unsigned xb_add(unsigned* p, unsigned v) { return __hip_atomic_fetch_add(p, v, __ATOMIC_RELAXED, __HIP_MEMORY_SCOPE_AGENT); }
__device__ __forceinline__ unsigned xb_xcc_id() { return (unsigned)__builtin_amdgcn_s_getreg((3 << 11) | 20) & 0xFu; }
#define XB_SPIN(cond, bar) do { unsigned _sp = 0; while (cond) { __builtin_amdgcn_s_sleep(1); \
    if ((++_sp & 255u) == 0u) { if (xb_ld(&(bar)[XB_TMO])) break; if (_sp > XB_SPIN_CAP) { atomicAdd(&(bar)[XB_TMO], 1u); break; } } } } while (0)
struct XcdBarrier { unsigned* bar; unsigned x; volatile LAS unsigned* st; };
__device__ __forceinline__ XcdBarrier xcd_barrier_post(unsigned* bar, volatile LAS unsigned* st) {
    XcdBarrier b; b.bar = bar; b.x = xb_xcc_id(); b.st = st;
    if (threadIdx.x == 0) (void)xb_add(&bar[XB_XCNT(b.x)], 1u);
    return b;
}
__device__ __forceinline__ void xcd_barrier_complete(unsigned* bar, unsigned x, unsigned& nloc, unsigned& nx) {
    const unsigned G = gridDim.x * gridDim.y * gridDim.z;
    unsigned sum, cnt, mine, sp = 0u;
    for (;;) {
        sum = 0u; cnt = 0u; mine = 0u;
#pragma unroll
        for (unsigned j = 0; j < 16; ++j) { const unsigned c = xb_ld(&bar[XB_XCNT(j)]); sum += c; cnt += (c > 0u) ? 1u : 0u; mine = (j == x) ? c : mine; }
        if (sum == G) break;
        __builtin_amdgcn_s_sleep(1);
        if ((++sp & 255u) == 0u) { if (xb_ld(&bar[XB_TMO])) break; if (sp > XB_SPIN_CAP) { atomicAdd(&bar[XB_TMO], 1u); break; } }
    }
    nloc = mine > 0u ? mine : 1u; nx = cnt > 0u ? cnt : 1u;
}
__device__ __forceinline__ void xcd_barrier(const XcdBarrier& b) {
    asm volatile("s_waitcnt vmcnt(0)" ::: "memory");
    __syncthreads();
    if (threadIdx.x == 0) {
        unsigned* bar = b.bar;
        __builtin_amdgcn_s_waitcnt(0);
        unsigned nloc = b.st[0], nx = b.st[1];
        if (nloc == 0u) { xcd_barrier_complete(bar, b.x, nloc, nx); b.st[0] = nloc; b.st[1] = nx; }
        const unsigned old = xb_add(&bar[XB_XSUB(b.x)], 1u);
        const unsigned gen = old / nloc;
        if (old + 1u == (gen + 1u) * nloc) {
            __builtin_amdgcn_fence(__ATOMIC_RELEASE, "agent");
            asm volatile("s_waitcnt vmcnt(0)" ::: "memory");
            const unsigned og = xb_add(&bar[XB_TOP], 1u);
            const unsigned tg = og / nx;
            if (og + 1u == (tg + 1u) * nx) xb_add(&bar[XB_TOPGEN], 1u);
            else XB_SPIN(xb_ld(&bar[XB_TOPGEN]) == tg, bar);
            __builtin_amdgcn_fence(__ATOMIC_ACQUIRE, "agent");
            xb_add(&bar[XB_XGEN(b.x)], 1u);
            asm volatile("s_waitcnt vmcnt(0)" ::: "memory");
        } else {
            XB_SPIN(xb_ld(&bar[XB_XGEN(b.x)]) == gen, bar);
            __builtin_amdgcn_fence(__ATOMIC_ACQUIRE, "agent");
            asm volatile("s_waitcnt vmcnt(0)" ::: "memory");
        }
    }
    __syncthreads();
}

#define GAS __attribute__((address_space(1)))
struct Frame {
    LAS unsigned char* lds;
    int tid, lane, wave, G, wg;
    GAS float* out;
    GAS unsigned char* ws;
};
#define WSP(T, off) ((T*)(F.ws + (off)))
#define INP(i) ((const float*)(((const GAS float* const LAS*)(F.lds + PTR_OFF))[i]))
__device__ __forceinline__ int row_vi(int row) { return row < NLAT ? (row >> 13) : 4; }
__device__ __forceinline__ int seq_lo(int row) { return row < NLAT ? (row & ~(SEQ - 1)) : (row & ~(CTXL - 1)); }
__device__ __forceinline__ int seq_hi(int row) { return row < NLAT ? (row | (SEQ - 1)) + 1 : (row | (CTXL - 1)) + 1; }

__device__ __attribute__((noinline)) void phase_mod(Frame F) {
    LAS float* sv = (LAS float*)F.lds;
    LAS float* red = (LAS float*)(F.lds + 20480);
    const float* c = INP(1); const float* cc = INP(3);
    for (int i = F.tid; i < 5 * 1024; i += NTHR) { const int v = i >> 10, k = i & 1023; const float x = v < 4 ? c[v * 1024 + k] : cc[k]; sv[i] = siluf_(x); }
    __syncthreads();
    if (F.wg == 0) for (int i = F.tid; i < 2 * 1024; i += NTHR) { const int jl = i >> 10, r = i & 1023; const float* lbl = INP(15);
        WSP(float, WS_OMT)[i] = jl == 0 ? 1.f : 1.f - sigmoidf_(lbl[1024 + r] - lbl[r]); }
    const int c4 = F.tid & 15, kg = F.tid >> 4;
    for (int u = F.wg; u < 4 * 96; u += F.G) {
        const int l = u / 96, n0 = (u % 96) * 64;
        const float* W = INP(4) + (size_t)l * 1024 * 6144;
        f32x4 acc[5];
#pragma unroll
        for (int v = 0; v < 5; ++v) acc[v] = (f32x4){0.f, 0.f, 0.f, 0.f};
#pragma unroll 4
        for (int kk = 0; kk < 32; ++kk) { const int k = kg * 32 + kk; const f32x4 w = *(const f32x4*)(W + (size_t)k * 6144 + n0 + 4 * c4);
#pragma unroll
            for (int v = 0; v < 5; ++v) acc[v] += w * sv[v * 1024 + k]; }
#pragma unroll
        for (int v = 0; v < 5; ++v)
#pragma unroll
            for (int i = 0; i < 4; ++i) red[(kg * 5 + v) * 64 + 4 * c4 + i] = acc[v][i];
        __syncthreads();
        if (F.tid < 320) { const int v = F.tid >> 6, col = F.tid & 63; float s = 0.f;
            for (int g = 0; g < 32; ++g) s += red[(g * 5 + v) * 64 + col];
            WSP(float, WS_MOD)[((size_t)l * 5 + v) * 6144 + n0 + col] = s + INP(5)[l * 6144 + n0 + col]; }
        __syncthreads();
    }
}

struct TDesc { const float* src; int ld, k0, sc, ncv; bf16* dst; int drow; };
__device__ __forceinline__ TDesc wdesc(Frame& F, int l, int it) {
    const int jl = l >> 1; const bool even = !(l & 1);
    const int ntn_in = even ? PE / 64 : PO / 64;
    const int I0 = 16 * ntn_in, I1 = 256, I2 = 16 * 16 * 32;
    TDesc d; int r = it;
    if (r < I0) { const int kt = r / ntn_in, nt = r % ntn_in, n0 = nt * 64; d.k0 = kt * 64; d.dst = WSP(bf16, WS_WIN); d.drow = n0;
        if (even) { d.src = INP(9) + (size_t)jl * 1024 * 4624; d.ld = 4624;
            if (n0 < 2048) { d.sc = n0; d.ncv = 64; } else if (n0 < 4608) { d.sc = n0 + 16; d.ncv = 64; } else if (n0 == 4608) { d.sc = 2048; d.ncv = 16; } else { d.sc = 0; d.ncv = 0; } }
        else { d.src = INP(17) + (size_t)jl * 1024 * 1792; d.ld = 1792; d.sc = n0; d.ncv = 64; }
        return d; }
    r -= I0;
    if (r < I1) { const int kt = r >> 4, nt = r & 15; d.src = (even ? INP(10) : INP(18)) + (size_t)jl * 1024 * 1024; d.ld = 1024; d.k0 = kt * 64; d.sc = nt * 64; d.ncv = 64; d.dst = WSP(bf16, WS_WOUT); d.drow = nt * 64; return d; }
    r -= I1;
    if (r < I2) { const int e = r >> 9, kt = (r >> 5) & 15, nt = r & 31, jt = nt >> 2, half = (nt >> 1) & 1, sub = nt & 1;
        d.src = (half ? INP(29) : INP(28)) + ((size_t)l * NE + e) * 1024 * 1024; d.ld = 1024; d.k0 = kt * 64; d.sc = jt * 128 + sub * 64; d.ncv = 64; d.dst = WSP(bf16, WS_W13) + (size_t)e * 2048 * 1024; d.drow = nt * 64; return d; }
    r -= I2;
    { const int e = r >> 8, kt = (r >> 4) & 15, nt = r & 15;
        d.src = INP(30) + ((size_t)l * NE + e) * 1024 * 1024; d.ld = 1024; d.k0 = kt * 64; d.sc = nt * 64; d.ncv = 64; d.dst = WSP(bf16, WS_W2) + (size_t)e * 1024 * 1024; d.drow = nt * 64; return d; }
}
__device__ __forceinline__ int witems_w2(int l) { return 16 * (!(l & 1) ? PE / 64 : PO / 64) + 256 + 16 * 16 * 32; }
__device__ __attribute__((noinline)) void phase_weights(Frame F, int l, int it0, int NI, int wg0) {
    asm volatile("s_nop 0\n s_nop 0\n s_nop 0\n s_nop 0\n s_nop 0\n s_nop 0\n s_nop 0\n s_nop 0");
    if (F.wg < wg0) return;
    const int r = F.tid >> 4, c4 = F.tid & 15, n = F.tid >> 3, kc = F.tid & 7;
    __syncthreads();
    for (int base = it0 + (F.wg - wg0) * 4; base < NI; base += (F.G - wg0) * 4) {
        f32x4 v[4][2]; TDesc d[4];
#pragma unroll
        for (int t = 0; t < 4; ++t) { v[t][0] = (f32x4){0.f, 0.f, 0.f, 0.f}; v[t][1] = v[t][0];
            if (base + t < NI) { d[t] = wdesc(F, l, base + t);
                if (4 * c4 < d[t].ncv) { v[t][0] = *(const f32x4*)(d[t].src + (size_t)(d[t].k0 + r) * d[t].ld + d[t].sc + 4 * c4); v[t][1] = *(const f32x4*)(d[t].src + (size_t)(d[t].k0 + 32 + r) * d[t].ld + d[t].sc + 4 * c4); } } }
#pragma unroll
        for (int t = 0; t < 4; ++t) { LAS float* scr = (LAS float*)(F.lds + t * 16640);
#pragma unroll
            for (int hh = 0; hh < 2; ++hh) { const int k = hh * 32 + r; scr[k * 65 + 4 * c4 + 0] = v[t][hh][0]; scr[k * 65 + 4 * c4 + 1] = v[t][hh][1]; scr[k * 65 + 4 * c4 + 2] = v[t][hh][2]; scr[k * 65 + 4 * c4 + 3] = v[t][hh][3]; } }
        __syncthreads();
#pragma unroll
        for (int t = 0; t < 4; ++t) if (base + t < NI) { const LAS float* scr = (const LAS float*)(F.lds + t * 16640); float f[8];
#pragma unroll
            for (int j = 0; j < 8; ++j) f[j] = scr[(8 * kc + j) * 65 + n];
            *(v4u*)(d[t].dst + (size_t)(d[t].drow + n) * 1024 + d[t].k0 + 8 * kc) = pack8(f); }
        __syncthreads();
    }
}

__device__ __forceinline__ void load_row_bf(const bf16* p, int lane, f32x4 (&v)[4]) {
#pragma unroll
    for (int j = 0; j < 4; ++j) { const v2u w = *(const v2u*)(p + 4 * lane + 256 * j); v[j] = (f32x4){bflo(w.x), bfhi(w.x), bflo(w.y), bfhi(w.y)}; }
}
__device__ __forceinline__ void store_row_bf(bf16* p, int lane, const f32x4 (&v)[4]) {
#pragma unroll
    for (int j = 0; j < 4; ++j) { v2u o; o.x = pk2(v[j][0], v[j][1]); o.y = pk2(v[j][2], v[j][3]); *(v2u*)(p + 4 * lane + 256 * j) = o; }
}
__device__ __forceinline__ void load_row(const float* p, int lane, f32x4 (&v)[4]) {
#pragma unroll
    for (int j = 0; j < 4; ++j) v[j] = *(const f32x4*)(p + 4 * lane + 256 * j);
}
constexpr int NPICK = 3;
struct CombBuf { v2u w[NPICK][4]; float wk[NPICK]; unsigned long long rest; };
__device__ __forceinline__ size_t comb_slot(int row, int e, int c) { return row < NLAT ? ((size_t)(e * 4 + (row >> 13)) * CAP_L + c) : ((size_t)NSLOT_L + e * 256 + ((row - NLAT) >> 8) * CAP_C + c); }
__device__ __forceinline__ void comb_issue(Frame& F, int row, int myc, CombBuf& cb) {
    const bf16* Y2 = WSP(bf16, WS_Y2); const float* GT = WSP(float, WS_GATES);
    unsigned long long mask = __ballot(myc >= 0);
#pragma unroll
    for (int k = 0; k < NPICK; ++k) { const bool ok = mask != 0ull; const int e = ok ? __builtin_ctzll(mask) : 0; mask &= mask - 1;
        const int c = ok ? __shfl(myc, e) : 0; const size_t slot = comb_slot(row, e, c); const bf16* yp = Y2 + slot * 1024; const float gt = GT[slot]; cb.wk[k] = ok ? gt : 0.f;
#pragma unroll
        for (int j = 0; j < 4; ++j) cb.w[k][j] = *(const v2u*)(yp + 4 * F.lane + 256 * j); }
    cb.rest = mask;
}
__device__ __forceinline__ void comb_finish(Frame& F, const LAS float* g2, int row, int myc, const CombBuf& cb, f32x4 (&v)[4]) {
    const bf16* Y2 = WSP(bf16, WS_Y2); const float* GT = WSP(float, WS_GATES);
    f32x4 s[4];
#pragma unroll
    for (int j = 0; j < 4; ++j) s[j] = (f32x4){0.f, 0.f, 0.f, 0.f};
#pragma unroll
    for (int k = 0; k < NPICK; ++k)
#pragma unroll
        for (int j = 0; j < 4; ++j) { s[j][0] += cb.wk[k] * bflo(cb.w[k][j].x); s[j][1] += cb.wk[k] * bfhi(cb.w[k][j].x); s[j][2] += cb.wk[k] * bflo(cb.w[k][j].y); s[j][3] += cb.wk[k] * bfhi(cb.w[k][j].y); }
    unsigned long long mask = cb.rest;
    while (mask) {
        const int e = __builtin_ctzll(mask); mask &= mask - 1;
        const int c = __shfl(myc, e); const size_t slot = comb_slot(row, e, c); const bf16* yp = Y2 + slot * 1024; const float gt = GT[slot];
#pragma unroll
        for (int j = 0; j < 4; ++j) { const v2u w = *(const v2u*)(yp + 4 * F.lane + 256 * j); s[j][0] += gt * bflo(w.x); s[j][1] += gt * bfhi(w.x); s[j][2] += gt * bflo(w.y); s[j][3] += gt * bfhi(w.y); }
    }
#pragma unroll
    for (int j = 0; j < 4; ++j) v[j] += s[j] * *(const LAS f32x4*)(g2 + 4 * F.lane + 256 * j);
}
__device__ __forceinline__ float row_rstd(const f32x4 (&v)[4]) {
    float s = 0.f;
#pragma unroll
    for (int j = 0; j < 4; ++j) s += (v[j][0] * v[j][0] + v[j][1] * v[j][1]) + (v[j][2] * v[j][2] + v[j][3] * v[j][3]);
    return __builtin_amdgcn_rsqf(wave_sum(s) * (1.f / DM) + EPS);
}
template <bool L0>
__device__ __attribute__((noinline)) void phase_rp1_t(Frame F, int l) {
    const int gw = F.wg * NWAVES + F.wave, NGW = F.G * NWAVES;
    LAS float* TA_ = (LAS float*)F.lds; LAS float* TB_ = TA_ + 5 * 1024; LAS float* TG_ = TB_ + 5 * 1024;
    { const float* nw = INP(6) + l * 1024;
      for (int i = F.tid; i < 5 * 1024; i += NTHR) { const int vi = i >> 10, c = i & 1023; const float* md = WSP(float, WS_MOD) + ((size_t)l * 5 + vi) * 6144;
          TA_[i] = nw[c] * (1.f + md[1024 + c]); TB_[i] = md[c]; if (!L0) TG_[i] = WSP(float, WS_MOD)[((size_t)(l - 1) * 5 + vi) * 6144 + 5120 + c]; }
      __syncthreads(); }
    const float* x0 = INP(0); const float* xc0 = INP(2);
    auto clampr = [&](int r) -> int { return r < ROWS ? r : ROWS - 1; };
    auto ldinv = [&](int r) -> int { const int c = WSP(int, WS_INV)[(size_t)clampr(r) * 16 + (F.lane & 15)]; return F.lane < 16 ? c : -1; };
    f32x4 vn[4]; v2u rn[4]; CombBuf cbn; int c0 = -1, c1 = -1;
    auto ldrow = [&](int row) {
        if (L0) { const float* pp = (row < NLAT ? x0 + (size_t)row * 1024 : xc0 + (size_t)(row - NLAT) * 1024) + 4 * F.lane;
#pragma unroll
            for (int j = 0; j < 4; ++j) vn[j] = *(const f32x4*)(pp + 256 * j); }
        else { const bf16* pp = WSP(bf16, WS_X) + (size_t)row * 1024 + 4 * F.lane;
#pragma unroll
            for (int j = 0; j < 4; ++j) rn[j] = *(const v2u*)(pp + 256 * j); } };
    { const int r0 = clampr(gw); ldrow(r0); if (!L0) { c0 = ldinv(gw); c1 = ldinv(gw + NGW); comb_issue(F, r0, c0, cbn); } }
    for (int row = gw; row < ROWS; row += NGW) {
        f32x4 v[4]; CombBuf cb; const int myc = c0;
#pragma unroll
        for (int j = 0; j < 4; ++j) v[j] = L0 ? vn[j] : (f32x4){bflo(rn[j].x), bfhi(rn[j].x), bflo(rn[j].y), bfhi(rn[j].y)};
        if (!L0) { cb = cbn; comb_finish(F, TG_ + row_vi(row) * 1024, row, myc, cb, v); }
        const int rnx = clampr(row + NGW);
        ldrow(rnx);
        if (!L0) { comb_issue(F, rnx, c1, cbn); c0 = c1; c1 = ldinv(row + 2 * NGW);
            store_row_bf(WSP(bf16, WS_X) + (size_t)row * 1024, F.lane, v); }
        const float rs = row_rstd(v);
        const LAS float* ta = TA_ + row_vi(row) * 1024; const LAS float* tb = TB_ + row_vi(row) * 1024;
        bf16* hp = WSP(bf16, WS_HN) + (size_t)row * 1024;
#pragma unroll
        for (int j = 0; j < 4; ++j) { const int col = 4 * F.lane + 256 * j; const f32x4 a = *(const LAS f32x4*)(ta + col), sh = *(const LAS f32x4*)(tb + col);
            const f32x4 h = (v[j] * rs) * a + sh; v2u o; o.x = pk2(h[0], h[1]); o.y = pk2(h[2], h[3]); *(v2u*)(hp + col) = o; }
    }
}
__device__ __forceinline__ float row16_max(float v) { v = fmaxf(v, dppf(v, 0)); v = fmaxf(v, dppf(v, 1)); v = fmaxf(v, dppf(v, 2)); v = fmaxf(v, dppf(v, 3)); return v; }
__device__ __attribute__((noinline)) void phase_rp2(Frame F, int l) {
    constexpr int HP = 2064;
    LAS float* TA_ = (LAS float*)F.lds; LAS float* TB_ = TA_ + 5 * 1024;
    LAS unsigned char* HH = F.lds + 40960; LAS unsigned char* HL = HH + 16 * HP; LAS float* PART = (LAS float*)(HL + 16 * HP);
    static_assert(40960 + 2 * 16 * HP + 8 * 16 * 17 * 4 <= MISC_OFF, "rp2 LDS map");
    { const float* nw = INP(7) + l * 1024;
      for (int i = F.tid; i < 5 * 1024; i += NTHR) { const int vi = i >> 10, c = i & 1023; const float* md = WSP(float, WS_MOD) + ((size_t)l * 5 + vi) * 6144; TA_[i] = nw[c] * (1.f + md[4096 + c]); TB_[i] = md[3072 + c]; } }
    const int li = F.lane & 15, lq = F.lane >> 4, w = F.wave;
    bf16x8 bh[4], bl[4];
    { const float* R = INP(27) + (size_t)l * 1024 * 16;
#pragma unroll
      for (int s = 0; s < 4; ++s) { unsigned hi[4], lo[4];
#pragma unroll
          for (int j2 = 0; j2 < 4; ++j2) { const int k = 128 * w + 32 * s + 8 * lq + 2 * j2; const float r0 = R[(size_t)k * 16 + li], r1 = R[(size_t)(k + 1) * 16 + li];
              hi[j2] = pk2(r0, r1); lo[j2] = pk2(r0 - bflo(hi[j2]), r1 - bfhi(hi[j2])); }
          bh[s] = __builtin_bit_cast(bf16x8, (v4u){hi[0], hi[1], hi[2], hi[3]}); bl[s] = __builtin_bit_cast(bf16x8, (v4u){lo[0], lo[1], lo[2], lo[3]}); } }
    __syncthreads();
    const int nrows = (l == DEPTH - 1) ? NLAT : ROWS, nblk = nrows >> 4;
    v2u nx[2][4];
    auto ldraw = [&](int blk) { const int b2 = blk < nblk ? blk : nblk - 1;
#pragma unroll
        for (int q = 0; q < 2; ++q) { const bf16* pp = WSP(bf16, WS_X) + (size_t)(16 * b2 + 2 * w + q) * 1024 + 4 * F.lane;
#pragma unroll
            for (int j = 0; j < 4; ++j) nx[q][j] = *(const v2u*)(pp + 256 * j); } };
    ldraw(F.wg);
    for (int blk = F.wg; blk < nblk; blk += F.G) {
        f32x4 h[2][4];
#pragma unroll
        for (int q = 0; q < 2; ++q)
#pragma unroll
            for (int j = 0; j < 4; ++j) h[q][j] = (f32x4){bflo(nx[q][j].x), bfhi(nx[q][j].x), bflo(nx[q][j].y), bfhi(nx[q][j].y)};
        ldraw(blk + F.G);
#pragma unroll
        for (int q = 0; q < 2; ++q) { const int row = 16 * blk + 2 * w + q;
            const float rs = row_rstd(h[q]);
            const LAS float* ta = TA_ + row_vi(row) * 1024; const LAS float* tb = TB_ + row_vi(row) * 1024;
            bf16* hp = WSP(bf16, WS_HN) + (size_t)row * 1024;
#pragma unroll
            for (int j = 0; j < 4; ++j) { const int col = 4 * F.lane + 256 * j; const f32x4 a = *(const LAS f32x4*)(ta + col), sh = *(const LAS f32x4*)(tb + col);
                const f32x4 x = (h[q][j] * rs) * a + sh; v2u o; o.x = pk2(x[0], x[1]); o.y = pk2(x[2], x[3]); *(v2u*)(hp + col) = o;
                v2u ol; ol.x = pk2(x[0] - bflo(o.x), x[1] - bfhi(o.x)); ol.y = pk2(x[2] - bflo(o.y), x[3] - bfhi(o.y));
                *(LAS v2u*)(HH + (2 * w + q) * HP + col * 2) = o; *(LAS v2u*)(HL + (2 * w + q) * HP + col * 2) = ol; } }
        __syncthreads();
        { f32x4 acc = (f32x4){0.f, 0.f, 0.f, 0.f};
          bf16x8 ah[4], al[4];
#pragma unroll
          for (int s = 0; s < 4; ++s) { const int ko = (128 * w + 32 * s + 8 * lq) * 2; ah[s] = *(const LAS bf16x8*)(HH + li * HP + ko); al[s] = *(const LAS bf16x8*)(HL + li * HP + ko); }
          __builtin_amdgcn_sched_barrier(0);
#pragma unroll
          for (int s = 0; s < 4; ++s) { acc = MFMA16(ah[s], bh[s], acc); acc = MFMA16(al[s], bh[s], acc); acc = MFMA16(ah[s], bl[s], acc); }
#pragma unroll
          for (int r = 0; r < 4; ++r) PART[(w * 16 + 4 * lq + r) * 17 + li] = acc[r]; }
        __syncthreads();
        if (F.tid < 256) { const int rr = F.tid >> 4, e = F.tid & 15, row = 16 * blk + rr; float lg = 0.f;
#pragma unroll
            for (int k = 0; k < 8; ++k) lg += PART[(k * 16 + rr) * 17 + e];
            const float mx = row16_max(lg), ex = __expf(lg - mx), den = row16_sum(ex);
            float* dst = row < NLAT ? WSP(float, WS_AFF) + ((size_t)((row >> 13) * 16 + e)) * SEQ + (row & (SEQ - 1)) : WSP(float, WS_AFF) + (size_t)NB * 16 * SEQ + ((size_t)(((row - NLAT) >> 8) * 16 + e)) * CTXL + ((row - NLAT) & (CTXL - 1));
            *dst = ex / den; }
    }
}
__device__ __attribute__((noinline)) void phase_final(Frame F) {
    const int gw = F.wg * NWAVES + F.wave, NGW = F.G * NWAVES;
    const float* nw = INP(8);
    LAS float* TG_ = (LAS float*)F.lds;
    for (int i = F.tid; i < 4 * 1024; i += NTHR) TG_[i] = WSP(float, WS_MOD)[((size_t)(DEPTH - 1) * 5 + (i >> 10)) * 6144 + 5120 + (i & 1023)];
    __syncthreads();
    auto clampr = [&](int r) -> int { return r < NLAT ? r : NLAT - 1; };
    auto ldinv = [&](int r) -> int { return F.lane < 16 ? WSP(int, WS_INV)[(size_t)clampr(r) * 16 + F.lane] : -1; };
    f32x4 vn[4]; CombBuf cbn; int c0 = -1, c1 = -1;
    if (gw < NLAT) { load_row_bf(WSP(bf16, WS_X) + (size_t)gw * 1024, F.lane, vn); c0 = ldinv(gw); c1 = ldinv(gw + NGW); comb_issue(F, gw, c0, cbn); }
    for (int row = gw; row < NLAT; row += NGW) {
        f32x4 v[4]; CombBuf cb = cbn; const int myc = c0;
#pragma unroll
        for (int j = 0; j < 4; ++j) v[j] = vn[j];
        const int rn = clampr(row + NGW);
        load_row_bf(WSP(bf16, WS_X) + (size_t)rn * 1024, F.lane, vn);
        comb_issue(F, rn, c1, cbn);
        c0 = c1; c1 = ldinv(row + 2 * NGW);
        comb_finish(F, TG_ + (row >> 13) * 1024, row, myc, cb, v);
        const float rs = row_rstd(v);
        float* op = (float*)(F.out + (size_t)row * 1024);
#pragma unroll
        for (int j = 0; j < 4; ++j) { const int col = 4 * F.lane + 256 * j; *(f32x4*)(op + col) = v[j] * rs * *(const f32x4*)(nw + col); }
    }
}

__device__ __forceinline__ bf16x8 frag_rm(const LAS unsigned char* base, int pitchB, int row0, int k0, int lane) {
    return *(const LAS bf16x8*)(base + (row0 + (lane & 15)) * pitchB + (k0 + 8 * (lane >> 4)) * 2);
}
__device__ __forceinline__ bf16x8 frag_tr(const LAS unsigned char* base, int pitchB, int krow0, int col0, int lane) {
    const int g = lane >> 4, i = lane & 15, qp = i >> 2, p = i & 3;
    const LAS unsigned char* a = base + (krow0 + 8 * g + qp) * pitchB + (col0 + 4 * p) * 2;
    const s16x4 lo = __builtin_bit_cast(s16x4, __builtin_amdgcn_ds_read_tr16_b64_v4i16((LAS s16x4*)a));
    const s16x4 hi = __builtin_bit_cast(s16x4, __builtin_amdgcn_ds_read_tr16_b64_v4i16((LAS s16x4*)(a + 4 * pitchB)));
    return (bf16x8){lo[0], lo[1], lo[2], lo[3], hi[0], hi[1], hi[2], hi[3]};
}
constexpr int NCHUNK = ROWS / 64  , NCU = NCHUNK * 4 * 2  ;
constexpr int LP = 272;
constexpr size_t CH_DU = WS_P, CH_DW = WS_P + 66 * MiB, CH_HQE = WS_P + 132 * MiB, CH_HKE = WS_P + 198 * MiB, CH_DQK = WS_P + 264 * MiB, CH_HA = WS_P + 297 * MiB,
                 CH_DCUM = WS_P + 330 * MiB, CH_HD = WS_P + 332 * MiB;
static_assert((size_t)NCU * 64 * 128 * 2 == 66 * MiB && (size_t)NCU * 64 * 64 * 2 == 33 * MiB && (size_t)NCU * 128 * 4 <= 3 * MiB, "chunk output map");

__device__ __attribute__((noinline)) void phase_even_prep(Frame F, int l) {
    const int jl = l >> 1;
    const int gw = F.wg * NWAVES + F.wave, NGW = F.G * NWAVES;
    const bf16* P = WSP(bf16, WS_P);
    const float* cw = INP(11) + (size_t)jl * 4 * 1536;
    for (int u = gw; u < NCHUNK * 3; u += NGW) {
        const int rb = u / 3, g = u - rb * 3, r0 = rb * 64, lo = seq_lo(r0), hi = seq_hi(r0);
        const int ch = g * 512 + F.lane * 8;
        float w[4][8];
#pragma unroll
        for (int j = 0; j < 4; ++j) { const f32x4 w0 = *(const f32x4*)(cw + j * 1536 + ch), w1 = *(const f32x4*)(cw + j * 1536 + ch + 4);
            w[j][0] = w0[0]; w[j][1] = w0[1]; w[j][2] = w0[2]; w[j][3] = w0[3]; w[j][4] = w1[0]; w[j][5] = w1[1]; w[j][6] = w1[2]; w[j][7] = w1[3]; }
        auto ld = [&](int t) -> v4u { const int row = r0 - 1 + t; const bool ok = (row >= lo) & (row < hi); const int rc = row < lo ? lo : (row >= hi ? hi - 1 : row);
            const v4u x = *(const v4u*)(P + (size_t)rc * PE + ch); v4u zz; zz.x = ok ? x.x : 0u; zz.y = ok ? x.y : 0u; zz.z = ok ? x.z : 0u; zz.w = ok ? x.w : 0u; return zz; };
        float win[4][8]; v4u pk[4];
#pragma unroll
        for (int t = 0; t < 4; ++t) unpack8(ld(t), win[t]);
#pragma unroll
        for (int t = 4; t < 8; ++t) pk[t & 3] = ld(t);
        bf16* dst = WSP(bf16, WS_QKVN) + (size_t)r0 * 1536 + ch;
#pragma unroll 4
        for (int i = 0; i < 64; ++i) {
            float a[8]; float ss = 0.f;
#pragma unroll
            for (int k = 0; k < 8; ++k) { float v = w[0][k] * win[i & 3][k] + w[1][k] * win[(i + 1) & 3][k] + w[2][k] * win[(i + 2) & 3][k] + w[3][k] * win[(i + 3) & 3][k]; v = siluf_(v); a[k] = v; ss += v * v; }
            if (g < 2) { ss = row16_sum(ss); const float rs = __builtin_amdgcn_rsqf(ss + EPS) * (g == 0 ? 0.08838834764831845f : 1.f);
#pragma unroll
                for (int k = 0; k < 8; ++k) a[k] *= rs; }
            *(v4u*)(dst + (size_t)i * 1536) = pack8(a);
            unpack8(pk[i & 3], win[i & 3]);
            pk[i & 3] = ld(i + 8);
        }
    }
}
template <int V> struct IntC { static constexpr int v = V; };
constexpr int DC_Q = 0, DC_K = 17408, DC_V = 34816, DC_KK = 52224, DC_QK = 69632, DC_TB = 87040, DC_TBE = 96256, DC_CUM = 105472, DC_BETA = 105728, DC_PA = 105984, DC_PB = 115200, DC_XA = DC_QK, DC_XB = DC_Q;
struct ChunkRegs { v4u t[6]; float g, b; };
__device__ __forceinline__ void chunk_delta_load(Frame& F, int cu, int tid, ChunkRegs& R) {
    const int z = cu & 1, h = (cu >> 1) & 3, r0 = (cu >> 3) * 64;
    const int tau = tid >> 3, c8 = tid & 7; const size_t row = (size_t)(r0 + (z ? 63 - tau : tau)); const bf16* src = WSP(bf16, WS_QKVN) + row * 1536 + h * 128;
#pragma unroll
    for (int hh = 0; hh < 2; ++hh) { const int col = hh * 64 + c8 * 8; R.t[hh] = *(const v4u*)(src + col); R.t[2 + hh] = *(const v4u*)(src + 512 + col); R.t[4 + hh] = *(const v4u*)(src + 1024 + col); }
    const int ts = tid & 63; const float* gb = WSP(float, WS_GB) + (size_t)(r0 + (z ? 63 - ts : ts)) * 16; R.g = gb[z * 4 + h]; R.b = gb[8 + z * 4 + h];
}
__device__ __forceinline__ void chunk_delta(Frame& F, int cu, int cu_next, ChunkRegs& R) {
    const int z = cu & 1, h = (cu >> 1) & 3, chunkId = cu >> 3, r0 = chunkId * 64;
    int tid = F.tid; asm volatile("" : "+v"(tid));
    const int lane = tid & 63, w = F.wave;
    LAS unsigned char* L = F.lds;
    LAS float* KKf = (LAS float*)(L + DC_KK); LAS float* QKf = (LAS float*)(L + DC_QK); LAS float* cum = (LAS float*)(L + DC_CUM); LAS float* bet = (LAS float*)(L + DC_BETA);
    __syncthreads();
    { const int tau = tid >> 3, c8 = tid & 7;
#pragma unroll
      for (int hh = 0; hh < 2; ++hh) { const int col = hh * 64 + c8 * 8;
          *(LAS v4u*)(L + DC_Q + tau * LP + col * 2) = R.t[hh]; *(LAS v4u*)(L + DC_K + tau * LP + col * 2) = R.t[2 + hh]; *(LAS v4u*)(L + DC_V + tau * LP + col * 2) = R.t[4 + hh]; } }
    float c = R.g; const float bt = R.b;
    chunk_delta_load(F, cu_next, tid, R);
    {
#pragma unroll
        for (int o = 1; o < 64; o <<= 1) { const float t = __shfl_up(c, o); if (lane >= o) c += t; }
        if (w == 0) { cum[lane] = c; bet[lane] = bt; WSP(float, CH_DCUM)[(size_t)cu * 64 + lane] = c; }
    }
    __syncthreads();
    { const int mt = w >> 1;
      bf16x8 fk[4], fq[4];
#pragma unroll
      for (int s = 0; s < 4; ++s) { fk[s] = frag_rm(L + DC_K, LP, 16 * mt, 32 * s, lane); fq[s] = frag_rm(L + DC_Q, LP, 16 * mt, 32 * s, lane); }
#pragma unroll
      for (int tt = 0; tt < 2; ++tt) { const int nt = 2 * (w & 1) + tt; bf16x8 fb[4];
#pragma unroll
        for (int s = 0; s < 4; ++s) fb[s] = frag_rm(L + DC_K, LP, 16 * nt, 32 * s, lane);
        __builtin_amdgcn_sched_barrier(0);
        f32x4 ak = (f32x4){0.f, 0.f, 0.f, 0.f}, aq = ak;
#pragma unroll
        for (int s = 0; s < 4; ++s) { ak = MFMA16(fk[s], fb[s], ak); aq = MFMA16(fq[s], fb[s], aq); }
#pragma unroll
        for (int r = 0; r < 4; ++r) { const int i = 16 * mt + 4 * (lane >> 4) + r, j = 16 * nt + (lane & 15); KKf[i * 68 + j] = ak[r]; QKf[i * 68 + j] = aq[r]; } } }
    __syncthreads();
    { const int i = tid >> 3, j0 = (tid & 7) * 8; const float ci = cum[i], bi = bet[i]; float qv[8];
      f32x4 kk[2], qq[2], cc[2];
#pragma unroll
      for (int hh = 0; hh < 2; ++hh) { kk[hh] = *(const LAS f32x4*)(KKf + i * 68 + j0 + 4 * hh); qq[hh] = *(const LAS f32x4*)(QKf + i * 68 + j0 + 4 * hh); cc[hh] = *(const LAS f32x4*)(cum + j0 + 4 * hh); }
#pragma unroll
      for (int jj = 0; jj < 8; ++jj) { const int j = j0 + jj; const float d = (j <= i) ? __expf(ci - cc[jj >> 2][jj & 3]) : 0.f;
          kk[jj >> 2][jj & 3] = (j < i) ? bi * kk[jj >> 2][jj & 3] * d : 0.f; qv[jj] = qq[jj >> 2][jj & 3] * d; }
#pragma unroll
      for (int hh = 0; hh < 2; ++hh) { *(LAS f32x4*)(KKf + i * 68 + j0 + 4 * hh) = kk[hh]; *(LAS f32x4*)(QKf + i * 68 + j0 + 4 * hh) = (f32x4){0.f, 0.f, 0.f, 0.f}; }
      *(v4u*)(WSP(bf16, CH_DQK) + ((size_t)cu * 64 + i) * 64 + j0) = pack8(qv); }
    __syncthreads();
    LAS float* TL = (LAS float*)(L + DC_QK); LAS float* YL = (LAS float*)(L + DC_Q);
    if (w == 0) { const int bb = lane >> 4, c = lane & 15; float t[16];
#pragma unroll
        for (int i = 0; i < 16; ++i) { float a0 = 0.f, a1 = 0.f;
#pragma unroll
            for (int j4 = 0; j4 < (i + 3) / 4; ++j4) { const f32x4 m4 = *(const LAS f32x4*)(KKf + (16 * bb + i) * 68 + 16 * bb + 4 * j4);
#pragma unroll
                for (int e2 = 0; e2 < 4; ++e2) if (4 * j4 + e2 < i) { if (e2 & 1) a1 += m4[e2] * t[4 * j4 + e2]; else a0 += m4[e2] * t[4 * j4 + e2]; } }
            t[i] = ((i == c) ? 1.f : 0.f) - (a0 + a1); TL[(16 * bb + i) * 68 + 16 * bb + c] = t[i]; } }
    __syncthreads();
#pragma unroll 1
    for (int LEV = 1; LEV <= 3; ++LEV) { const int nb = 4 - LEV;
        for (int e2 = tid; e2 < nb * 256; e2 += NTHR) { const int bj = e2 >> 8, bi = bj + LEV, i = (e2 >> 4) & 15, j = e2 & 15;
            float acc = 0.f, a1 = 0.f, a2 = 0.f, a3 = 0.f;
#pragma unroll 1
            for (int kb = 0; kb < LEV; ++kb) {
                f32x4 m4[4]; float tv[16];
#pragma unroll
                for (int kk = 0; kk < 4; ++kk) { const int k = 16 * (bj + kb) + 4 * kk; m4[kk] = *(const LAS f32x4*)(KKf + (16 * bi + i) * 68 + k);
#pragma unroll
                    for (int r = 0; r < 4; ++r) tv[4 * kk + r] = TL[(k + r) * 68 + 16 * bj + j]; }
                __builtin_amdgcn_sched_barrier(0);
#pragma unroll
                for (int kk = 0; kk < 4; ++kk) { acc += m4[kk][0] * tv[4 * kk]; a1 += m4[kk][1] * tv[4 * kk + 1]; a2 += m4[kk][2] * tv[4 * kk + 2]; a3 += m4[kk][3] * tv[4 * kk + 3]; }
                __builtin_amdgcn_sched_barrier(0); }
            YL[(bj * 16 + i) * 17 + j] = (acc + a1) + (a2 + a3); }
        __syncthreads();
        for (int e2 = tid; e2 < nb * 256; e2 += NTHR) { const int bj = e2 >> 8, bi = bj + LEV, i = (e2 >> 4) & 15, j = e2 & 15;
            f32x4 d4[4]; float yv[16];
#pragma unroll
            for (int kk = 0; kk < 4; ++kk) { d4[kk] = *(const LAS f32x4*)(TL + (16 * bi + i) * 68 + 16 * bi + 4 * kk);
#pragma unroll
                for (int r = 0; r < 4; ++r) yv[4 * kk + r] = YL[(bj * 16 + 4 * kk + r) * 17 + j]; }
            __builtin_amdgcn_sched_barrier(0);
            float acc = 0.f;
#pragma unroll
            for (int kk = 0; kk < 4; ++kk) acc += (d4[kk][0] * yv[4 * kk] + d4[kk][1] * yv[4 * kk + 1]) + (d4[kk][2] * yv[4 * kk + 2] + d4[kk][3] * yv[4 * kk + 3]);
            TL[(16 * bi + i) * 68 + 16 * bj + j] = -acc; }
        __syncthreads(); }
    { LAS bf16* tb = (LAS bf16*)(L + DC_TB); LAS bf16* tbe = (LAS bf16*)(L + DC_TBE);
      const int i = tid >> 3, j0 = (tid & 7) * 8; float t1[8], t2[8];
      f32x4 tt4[2], bb4[2], cc4[2];
#pragma unroll
      for (int hh = 0; hh < 2; ++hh) { tt4[hh] = *(const LAS f32x4*)(TL + i * 68 + j0 + 4 * hh); bb4[hh] = *(const LAS f32x4*)(bet + j0 + 4 * hh); cc4[hh] = *(const LAS f32x4*)(cum + j0 + 4 * hh); }
#pragma unroll
      for (int jj = 0; jj < 8; ++jj) { const float tv = tt4[jj >> 2][jj & 3], bc = bb4[jj >> 2][jj & 3]; t1[jj] = tv * bc; t2[jj] = tv * bc * __expf(cc4[jj >> 2][jj & 3]); }
      *(LAS v4u*)(tb + i * 72 + j0) = pack8(t1); *(LAS v4u*)(tbe + i * 72 + j0) = pack8(t2); }
    __syncthreads();
    { bf16* DU = WSP(bf16, CH_DU) + (size_t)cu * 8192; bf16* DW = WSP(bf16, CH_DW) + (size_t)cu * 8192;
      bf16x8 av[2], ak2[2];
#pragma unroll
      for (int s = 0; s < 2; ++s) { av[s] = frag_tr(L + DC_V, LP, 32 * s, 16 * w, lane); ak2[s] = frag_tr(L + DC_K, LP, 32 * s, 16 * w, lane); }
#pragma unroll
      for (int nt = 0; nt < 4; ++nt) { f32x4 au = (f32x4){0.f, 0.f, 0.f, 0.f}, aw = au;
          bf16x8 ftb[2], fte[2];
#pragma unroll
          for (int s = 0; s < 2; ++s) { ftb[s] = frag_rm(L + DC_TB, 144, 16 * nt, 32 * s, lane); fte[s] = frag_rm(L + DC_TBE, 144, 16 * nt, 32 * s, lane); }
          __builtin_amdgcn_sched_barrier(0);
#pragma unroll
          for (int s = 0; s < 2; ++s) { au = MFMA16(av[s], ftb[s], au); aw = MFMA16(ak2[s], fte[s], aw); }
          const int i = 16 * nt + (lane & 15), n = 16 * w + 4 * (lane >> 4);
          v2u o; o.x = pk2(au[0], au[1]); o.y = pk2(au[2], au[3]); *(LAS v2u*)(L + DC_KK + i * LP + n * 2) = o;
          o.x = pk2(aw[0], aw[1]); o.y = pk2(aw[2], aw[3]); *(LAS v2u*)(L + DC_QK + i * LP + n * 2) = o; }
      __syncthreads();
      { const int tau = tid >> 3, c8 = tid & 7;
#pragma unroll
        for (int hh = 0; hh < 2; ++hh) { const int col = hh * 64 + c8 * 8;
            *(v4u*)(DU + tau * 128 + col) = *(const LAS v4u*)(L + DC_KK + tau * LP + col * 2); *(v4u*)(DW + tau * 128 + col) = *(const LAS v4u*)(L + DC_QK + tau * LP + col * 2); } } }
}

constexpr int HC_Q = 0, HC_K = 17408, HC_ELL = 34816, HC_REF = 68608, HC_TOT = 70656, HC_KI = 72704;
__device__ __forceinline__ void chunk_hgrn_load(Frame& F, int cu, int tid, ChunkRegs& R) {
    const int z = cu & 1, h = (cu >> 1) & 3, r0 = (cu >> 3) * 64;
    const int tau = tid >> 3, c8 = tid & 7; const size_t row = (size_t)(r0 + (z ? 63 - tau : tau));
#pragma unroll
    for (int hh = 0; hh < 2; ++hh) { const int col = hh * 64 + c8 * 8; R.t[hh] = *(const v4u*)(WSP(bf16, WS_HQ) + row * 512 + h * 128 + col); R.t[2 + hh] = *(const v4u*)(WSP(bf16, WS_HK) + row * 1024 + z * 512 + h * 128 + col); }
}
__device__ __forceinline__ void chunk_hgrn(Frame& F, int cu, int cu_next, ChunkRegs& R) {
    const int z = cu & 1, h = (cu >> 1) & 3, chunkId = cu >> 3, r0 = chunkId * 64;
    int tid = F.tid; asm volatile("" : "+v"(tid));
    const int lane = tid & 63, w = F.wave;
    LAS unsigned char* L = F.lds;
    LAS float* ell = (LAS float*)(L + HC_ELL); LAS float* ref = (LAS float*)(L + HC_REF); LAS float* tot = (LAS float*)(L + HC_TOT);
    __syncthreads();
    { const int tau = tid >> 3, c8 = tid & 7;
#pragma unroll
      for (int hh = 0; hh < 2; ++hh) { const int col = hh * 64 + c8 * 8; *(LAS v4u*)(L + HC_Q + tau * LP + col * 2) = R.t[hh]; *(LAS v4u*)(L + HC_K + tau * LP + col * 2) = R.t[2 + hh]; } }
    chunk_hgrn_load(F, cu_next, tid, R);
    __syncthreads();
    { const int I = tid >> 7, d = tid & 127; float c = 0.f;
#pragma unroll
      for (int t = 0; t < 16; ++t) { const float kk = bf1(*(const LAS bf16*)(L + HC_K + (16 * I + t) * LP + d * 2)); c += __builtin_amdgcn_logf(1.f - kk); ell[(16 * I + t) * 132 + d] = c; }
      tot[I * 128 + d] = c; }
    __syncthreads();
    { const int I = tid >> 7, d = tid & 127; float r = 0.f;
      for (int i2 = 0; i2 < I; ++i2) r += tot[i2 * 128 + d];
      ref[I * 128 + d] = r; }
    __syncthreads();
    { const int tau = tid >> 3, c8 = tid & 7, I = tau >> 4;
#pragma unroll
      for (int hh = 0; hh < 2; ++hh) { const int d0 = hh * 64 + c8 * 8; float q[8], k[8], qt[8], qe[8], ke[8];
          unpack8(*(const LAS v4u*)(L + HC_Q + tau * LP + d0 * 2), q); unpack8(*(const LAS v4u*)(L + HC_K + tau * LP + d0 * 2), k);
          float bb[8];
#pragma unroll
          for (int e = 0; e < 8; ++e) { const int d = d0 + e; const float el = ell[tau * 132 + d]; const float b = ref[I * 128 + d] + el; const float bL = ref[3 * 128 + d] + ell[63 * 132 + d];
              bb[e] = b; qt[e] = q[e] * __builtin_amdgcn_exp2f(el); qe[e] = q[e] * __builtin_amdgcn_exp2f(b); ke[e] = k[e] * __builtin_amdgcn_exp2f(bL - b);
              if (tau == 0) WSP(float, CH_HD)[(size_t)cu * 128 + d] = __builtin_amdgcn_exp2f(bL); }
          *(LAS v4u*)(L + HC_Q + tau * LP + d0 * 2) = pack8(qt);
          *(v4u*)(WSP(bf16, CH_HQE) + ((size_t)cu * 64 + tau) * 128 + d0) = pack8(qe);
          *(v4u*)(WSP(bf16, CH_HKE) + ((size_t)cu * 64 + tau) * 128 + d0) = pack8(ke);
#pragma unroll
          for (int I2 = 0; I2 < 4; ++I2) if (I2 >= I) { float ki[8];
#pragma unroll
              for (int e = 0; e < 8; ++e) ki[e] = k[e] * __builtin_amdgcn_exp2f(fminf(ref[I2 * 128 + d0 + e] - bb[e], 115.41560327111707f));
              *(LAS v4u*)(L + HC_KI + (8 * I2 * (I2 + 1) + tau) * LP + d0 * 2) = pack8(ki); } } }
    __syncthreads();
    { bf16* HA = WSP(bf16, CH_HA) + (size_t)cu * 4096;
      for (int t = w; t < 16; t += 8) { const int I2 = t >> 2, J = t & 3;
          f32x4 a = (f32x4){0.f, 0.f, 0.f, 0.f};
          if (J <= I2) { bf16x8 fa[4], fb[4];
#pragma unroll
              for (int s = 0; s < 4; ++s) { fa[s] = frag_rm(L + HC_KI, LP, 8 * I2 * (I2 + 1) + 16 * J, 32 * s, lane); fb[s] = frag_rm(L + HC_Q, LP, 16 * I2, 32 * s, lane); }
              __builtin_amdgcn_sched_barrier(0);
#pragma unroll
              for (int s = 0; s < 4; ++s) a = MFMA16(fa[s], fb[s], a); }
          const int i = 16 * I2 + (lane & 15), j = 16 * J + 4 * (lane >> 4);
          v2u o; o.x = pk2(j <= i ? a[0] : 0.f, j + 1 <= i ? a[1] : 0.f); o.y = pk2(j + 2 <= i ? a[2] : 0.f, j + 3 <= i ? a[3] : 0.f);
          *(v2u*)(HA + i * 64 + j) = o; } }
}
__device__ __attribute__((noinline)) void phase_even_chunk_d(Frame F) {
    if (F.wg >= NCU) return;
    ChunkRegs R; chunk_delta_load(F, F.wg, F.tid, R);
    for (int u = F.wg; u < NCU; u += F.G) chunk_delta(F, u, u + F.G < NCU ? u + F.G : u, R);
    __syncthreads(); }
__device__ __attribute__((noinline)) void phase_even_chunk_h(Frame F) {
    const int w0 = (F.wg + (F.G >> 1)) % F.G;
    if (w0 >= NCU) return;
    ChunkRegs R; chunk_hgrn_load(F, w0, F.tid, R);
    for (int u = w0; u < NCU; u += F.G) chunk_hgrn(F, u, u + F.G < NCU ? u + F.G : u, R);
    __syncthreads(); }

constexpr int SB_A = 0, SB_B = 16384, SB_C = 32768, SB_QK = 49152, SB_U = 57344, SB_CUM = 61440, SB_SZ = 61952;
constexpr int SS_ST = 2 * SB_SZ, SS_VT = SS_ST + 8704, SS_VST = SS_VT + 4608, SS_OB = SS_VST + 4608;
constexpr int SS_JUNK = SS_OB + 4096;
static_assert(SS_JUNK + 256 <= MISC_OFF, "scan LDS map");
template <int MIX>
__device__ __forceinline__ void scan_chunks(Frame& F, int chain, int slice) {
    const int b = chain >> 3, z = (chain >> 2) & 1, h = chain & 3, dv0 = slice * 32;
    int tid = F.tid; asm volatile("" : "+v"(tid)); int lane = tid & 63, li = lane & 15, lq = lane >> 4; const int w = F.wave;
    LAS unsigned char* L = F.lds;
    bf16* odst = (z == 0 ? WSP(bf16, WS_HN) : WSP(bf16, WS_ODIR) + (size_t)ROWS * 1024) + MIX * 512 + h * 128 + dv0;
    auto chunk_of = [&](int blk) -> int { return blk < 4 ? 512 + b * 4 + (z ? 3 - blk : blk) : b * 128 + (z ? 127 - (blk - 4) : (blk - 4)); };
#define DMA16(src, dst) __builtin_amdgcn_global_load_lds((const unsigned*)(src), (LAS unsigned*)(dst), 16, 0, 0)
#define DMA4(src, dst) __builtin_amdgcn_global_load_lds((const unsigned*)(src), (LAS unsigned*)(dst), 4, 0, 0)
    unsigned oA[2], oB[2], oQK, oU, oCUM;
#pragma unroll
    for (int i = 0; i < 2; ++i) { const int kk = w + 8 * i, r = 4 * kk + (lane >> 4), c = (lane & 15) ^ (r & 15);
        oA[i] = (unsigned)(r * 128 + c * 8) * 2u; oB[i] = (unsigned)((z ? 63 - r : r) * 1536 + h * 128 + c * 8) * 2u; }
    { const int r = 8 * w + (lane >> 3), c = (lane & 7) ^ ((r >> 1) & 7); oQK = (unsigned)(r * 64 + c * 8) * 2u; }
    { const int r = 16 * (w & 3) + (lane >> 2), c = lane & 3;
      oU = MIX == 0 ? (unsigned)(r * 128 + dv0 + c * 8) * 2u : (unsigned)((z ? 63 - r : r) * 512 + h * 128 + dv0 + c * 8) * 2u; }
    oCUM = (unsigned)(MIX == 0 ? lane : (w & 1) * 64 + lane) * 4u;
    auto gload = [&](int blk_, int buf) {
        const int blk = blk_ < 131 ? blk_ : 131;
        const int chunkId = chunk_of(blk); const size_t cu = ((size_t)chunkId * 4 + h) * 2 + z; const size_t r0 = (size_t)chunkId * 64;
        LAS unsigned char* D = L + buf * SB_SZ;
        const char* bA = (const char*)(MIX == 0 ? WSP(bf16, CH_DW) : WSP(bf16, CH_HQE)) + cu * (64 * 128 * 2);
        const char* bB = MIX == 0 ? (const char*)WSP(bf16, WS_QKVN) + r0 * (1536 * 2) : (const char*)WSP(bf16, CH_HKE) + cu * (64 * 128 * 2);
        const char* bQ = (const char*)(MIX == 0 ? WSP(bf16, CH_DQK) : WSP(bf16, CH_HA)) + cu * (64 * 64 * 2);
        const char* bU = MIX == 0 ? (const char*)WSP(bf16, CH_DU) + cu * (64 * 128 * 2) : (const char*)WSP(bf16, WS_IB) + r0 * (512 * 2);
        const char* bC = MIX == 0 ? (const char*)WSP(float, CH_DCUM) + cu * (64 * 4) : (const char*)WSP(float, CH_HD) + cu * (128 * 4);
#pragma unroll
        for (int i = 0; i < 2; ++i) { const int kk = w + 8 * i;
            DMA16(bA + oA[i], D + SB_A + kk * 1024);
            if (MIX == 0) { DMA16(bB + oB[i], D + SB_B + kk * 1024); DMA16(bB + 1024 + oB[i], D + SB_C + kk * 1024); }
            else DMA16(bB + oA[i], D + SB_B + kk * 1024); }
        DMA16(bQ + oQK, D + SB_QK + w * 1024);
        if (w < 4) DMA16(bU + oU, D + SB_U + w * 1024);
        if (MIX == 0) { if (w == 4) DMA4(bC + oCUM, D + SB_CUM); }
        else { if (w == 4 || w == 5) DMA4(bC + oCUM, D + SB_CUM + (w - 4) * 256); }
    };
    int psel; unsigned oP;
    if (w < 2) { const int row = w * 32 + (lane >> 1), half = lane & 1;
        if (MIX == 0) { psel = slice; oP = slice == 0 ? (unsigned)(row * 256 + half * 128) : slice == 3 ? (unsigned)(lane * 128) : (unsigned)((z ? 63 - row : row) * 3072 + h * 256 + half * 128 + (slice == 2 ? 1024 : 0)); }
        else { psel = slice == 0 ? 0 : slice == 1 ? 1 : slice == 2 ? 3 : 5; oP = slice < 2 ? (unsigned)(row * 256 + half * 128) : slice == 2 ? (unsigned)(lane * 128) : 0u; } }
    else if (w == 2) { psel = 4; oP = MIX == 0 ? (unsigned)(lane * 256 + dv0 * 2) : (unsigned)((z ? 63 - lane : lane) * 1024 + h * 256 + dv0 * 2); }
    else { psel = 5; oP = w == 3 ? (unsigned)((lane & (MIX == 0 ? 1 : 3)) * 128) : 0u; }
    psel = __builtin_amdgcn_readfirstlane(psel);
    auto pfetch = [&](int blk_) {
        const int blk = blk_ < 131 ? blk_ : 131;
        const int chunkId = chunk_of(blk); const size_t cu = ((size_t)chunkId * 4 + h) * 2 + z; const size_t r0 = (size_t)chunkId * 64;
        const char* bA = (const char*)(MIX == 0 ? WSP(bf16, CH_DW) : WSP(bf16, CH_HQE)) + cu * (64 * 128 * 2);
        const char* bB = MIX == 0 ? (const char*)WSP(bf16, WS_QKVN) + r0 * (1536 * 2) : (const char*)WSP(bf16, CH_HKE) + cu * (64 * 128 * 2);
        const char* bQ = (const char*)(MIX == 0 ? WSP(bf16, CH_DQK) : WSP(bf16, CH_HA)) + cu * (64 * 64 * 2);
        const char* bU = MIX == 0 ? (const char*)WSP(bf16, CH_DU) + cu * (64 * 128 * 2) : (const char*)WSP(bf16, WS_IB) + r0 * (512 * 2);
        const char* bC = MIX == 0 ? (const char*)WSP(float, CH_DCUM) + cu * (64 * 4) : (const char*)WSP(float, CH_HD) + cu * (128 * 4);
        const char* pb = psel == 0 ? bA : (psel == 1 || psel == 2) ? bB : psel == 3 ? bQ : psel == 4 ? bU : bC;
        DMA4(pb + oP, L + SS_JUNK);
    };
    f32x4 S[2];
    S[0] = (f32x4){0.f, 0.f, 0.f, 0.f}; S[1] = S[0];
    __syncthreads();
    for (int i = tid; i < 32 * 136 / 2; i += NTHR) ((LAS unsigned*)(L + SS_ST))[i] = 0u;
    gload(0, 0); pfetch(1);
    asm volatile("s_waitcnt vmcnt(0) lgkmcnt(0)" ::: "memory"); __builtin_amdgcn_s_barrier(); asm volatile("" ::: "memory");
    const int mt = w >> 1, nt = w & 1;
#define LDF(p) (*(const LAS bf16x8*)(p))
#define TRR(p) ({ v2u _r; asm volatile("ds_read_b64_tr_b16 %0, %1" : "=v"(_r) : "v"((unsigned)(size_t)(p))); _r; })
#define TRW4(a, b, c, d) asm volatile("s_waitcnt lgkmcnt(0)" : "+v"(a), "+v"(b), "+v"(c), "+v"(d))
#define TRJ(lo, hi) __builtin_bit_cast(bf16x8, (v4u){(lo).x, (lo).y, (hi).x, (hi).y})
    auto ostore = [&](int blk) {
        if (tid < 256) { const int r0 = chunk_of(blk) * 64, tau = tid >> 2, c = tid & 3; *(v4u*)(odst + (size_t)(r0 + (z ? 63 - tau : tau)) * 1024 + c * 8) = *(const LAS v4u*)(L + SS_OB + tau * 64 + c * 16); } };
#define SCHED_FENCE __builtin_amdgcn_sched_barrier(0)
    for (int blk = 0; blk < 132; ++blk) {
        LAS unsigned char* D = L + (blk & 1) * SB_SZ;
        const LAS float* cumL = (const LAS float*)(D + SB_CUM);
        const int qp = li >> 2, pp = li & 3;
        LAS unsigned char* aST = L + SS_ST + li * LP + lq * 16; LAS unsigned char* a144 = L + li * 144 + lq * 16;
        f32x4 oacc = (f32x4){0.f, 0.f, 0.f, 0.f};
        if (MIX == 0) {
            gload(blk + 1, (blk + 1) & 1);
            SCHED_FENCE;
            bf16x8 fS[4], fW[4], fQ[4];
            { const LAS unsigned char* pW = D + SB_A + (16 * mt + li) * 256; const LAS unsigned char* pQ = D + SB_B + (16 * mt + li) * 256; LAS unsigned char* pS = aST + nt * (16 * LP);
#pragma unroll
              for (int s = 0; s < 4; ++s) { const int so = ((4 * s + lq) ^ li) << 4; fS[s] = LDF(pS + 64 * s); fW[s] = LDF(pW + so); fQ[s] = LDF(pQ + so); } }
            const float cL = cumL[63]; const f32x4 ct4 = *(const LAS f32x4*)(cumL + 16 * mt + 4 * lq); float u4[4];
#pragma unroll
            for (int r = 0; r < 4; ++r) u4[r] = bf1(*(const LAS bf16*)(D + SB_U + (16 * mt + 4 * lq + r) * 64 + (16 * nt + li) * 2));
            SCHED_FENCE;
            f32x4 aW = oacc, aQ = oacc;
#pragma unroll
            for (int s = 0; s < 4; ++s) { aW = MFMA16(fW[s], fS[s], aW); aQ = MFMA16(fQ[s], fS[s], aQ); }
            SCHED_FENCE;
            if (blk > 0) ostore(blk - 1);
            pfetch(blk + 2);
            SCHED_FENCE;
            float vn[4], vs[4];
#pragma unroll
            for (int r = 0; r < 4; ++r) { vn[r] = u4[r] - aW[r]; vs[r] = vn[r] * __expf(cL - ct4[r]); oacc[r] = aQ[r] * __expf(ct4[r]); }
            const float gl = __expf(cL);
            { v2u o; o.x = pk2(vn[0], vn[1]); o.y = pk2(vn[2], vn[3]); *(LAS v2u*)(L + SS_VT + (16 * nt + li) * 144 + (16 * mt + 4 * lq) * 2) = o;
              o.x = pk2(vs[0], vs[1]); o.y = pk2(vs[2], vs[3]); *(LAS v2u*)(L + SS_VST + (16 * nt + li) * 144 + (16 * mt + 4 * lq) * 2) = o; }
            asm volatile("s_waitcnt lgkmcnt(0)" ::: "memory"); __builtin_amdgcn_s_barrier(); asm volatile("" ::: "memory");
            v2u kr[2][2]; bf16x8 fV[2][2], fA[2], fT[2];
#pragma unroll
            for (int s = 0; s < 2; ++s) { const int r = 32 * s + 8 * lq + qp; const LAS unsigned char* p0 = D + SB_C + r * 256 + (((2 * w + (pp >> 1)) ^ (r & 15)) << 4) + (pp & 1) * 8;
                const int r4 = r + 4; const LAS unsigned char* p1 = D + SB_C + r4 * 256 + (((2 * w + (pp >> 1)) ^ (r4 & 15)) << 4) + (pp & 1) * 8;
                kr[s][0] = TRR(p0); kr[s][1] = TRR(p1); }
#pragma unroll
            for (int n2 = 0; n2 < 2; ++n2) { fV[n2][0] = LDF(a144 + SS_VST + n2 * (16 * 144)); fV[n2][1] = LDF(a144 + SS_VST + n2 * (16 * 144) + 64); }
            { const int r = 16 * mt + li; const LAS unsigned char* pA = D + SB_QK + r * 128; LAS unsigned char* pV = a144 + SS_VT + nt * (16 * 144);
              fA[0] = LDF(pA + ((lq ^ ((r >> 1) & 7)) << 4)); fA[1] = LDF(pA + (((4 + lq) ^ ((r >> 1) & 7)) << 4)); fT[0] = LDF(pV); fT[1] = LDF(pV + 64); }
            SCHED_FENCE;
            TRW4(kr[0][0], kr[0][1], kr[1][0], kr[1][1]);
            const bf16x8 kT0 = TRJ(kr[0][0], kr[0][1]), kT1 = TRJ(kr[1][0], kr[1][1]);
            f32x4 a0 = S[0] * gl, a1 = S[1] * gl;
            a0 = MFMA16(kT0, fV[0][0], a0); a1 = MFMA16(kT0, fV[1][0], a1); oacc = MFMA16(fA[0], fT[0], oacc);
            a0 = MFMA16(kT1, fV[0][1], a0); a1 = MFMA16(kT1, fV[1][1], a1); oacc = MFMA16(fA[1], fT[1], oacc);
            S[0] = a0; S[1] = a1;
        } else {
            bf16x8 fQ[4], fS[4], fA[2]; v2u vr[4][2], kr[2][2];
            { const LAS unsigned char* pA = D + SB_A + (16 * mt + li) * 256; LAS unsigned char* pS = aST + nt * (16 * LP);
#pragma unroll
              for (int s = 0; s < 4; ++s) { fQ[s] = LDF(pA + (((4 * s + lq) ^ li) << 4)); fS[s] = LDF(pS + 64 * s); } }
            const LAS unsigned char* pV = D + SB_U + (8 * lq + qp) * 64 + pp * 8;
#pragma unroll
            for (int q4 = 0; q4 < 4; ++q4) { const LAS unsigned char* pq = pV + (q4 & 1) * (32 * 64) + (q4 >> 1) * 32; vr[q4][0] = TRR(pq); vr[q4][1] = TRR(pq + 4 * 64); }
#pragma unroll
            for (int s = 0; s < 2; ++s) { const int r = 32 * s + 8 * lq + qp; const LAS unsigned char* p0 = D + SB_B + r * 256 + (((2 * w + (pp >> 1)) ^ (r & 15)) << 4) + (pp & 1) * 8;
                const int r4 = r + 4; const LAS unsigned char* p1 = D + SB_B + r4 * 256 + (((2 * w + (pp >> 1)) ^ (r4 & 15)) << 4) + (pp & 1) * 8;
                kr[s][0] = TRR(p0); kr[s][1] = TRR(p1); }
            { const int r = 16 * mt + li; const LAS unsigned char* pA = D + SB_QK + r * 128; fA[0] = LDF(pA + ((lq ^ ((r >> 1) & 7)) << 4)); fA[1] = LDF(pA + (((4 + lq) ^ ((r >> 1) & 7)) << 4)); }
            const f32x4 dd = *(const LAS f32x4*)(cumL + 16 * w + 4 * lq);
            SCHED_FENCE;
            gload(blk + 1, (blk + 1) & 1);
            SCHED_FENCE;
            TRW4(vr[0][0], vr[0][1], vr[1][0], vr[1][1]); TRW4(vr[2][0], vr[2][1], vr[3][0], vr[3][1]); TRW4(kr[0][0], kr[0][1], kr[1][0], kr[1][1]);
            const bf16x8 v00 = TRJ(vr[0][0], vr[0][1]), v01 = TRJ(vr[1][0], vr[1][1]), v10 = TRJ(vr[2][0], vr[2][1]), v11 = TRJ(vr[3][0], vr[3][1]);
            const bf16x8 kT0 = TRJ(kr[0][0], kr[0][1]), kT1 = TRJ(kr[1][0], kr[1][1]);
            f32x4 a0 = S[0] * dd, a1 = S[1] * dd;
            oacc = MFMA16(fQ[0], fS[0], oacc); a0 = MFMA16(kT0, v00, a0); a1 = MFMA16(kT0, v10, a1);
            oacc = MFMA16(fQ[1], fS[1], oacc); a0 = MFMA16(kT1, v01, a0); a1 = MFMA16(kT1, v11, a1);
            oacc = MFMA16(fQ[2], fS[2], oacc); oacc = MFMA16(fQ[3], fS[3], oacc);
            oacc = MFMA16(fA[0], nt ? v10 : v00, oacc); oacc = MFMA16(fA[1], nt ? v11 : v01, oacc);
            S[0] = a0; S[1] = a1;
            SCHED_FENCE;
            if (blk > 0) ostore(blk - 1);
            pfetch(blk + 2);
            SCHED_FENCE;
            asm volatile("s_waitcnt lgkmcnt(0)" ::: "memory"); __builtin_amdgcn_s_barrier(); asm volatile("" ::: "memory");
        }
#pragma unroll
        for (int n2 = 0; n2 < 2; ++n2) { v2u o; o.x = pk2(S[n2][0], S[n2][1]); o.y = pk2(S[n2][2], S[n2][3]); *(LAS v2u*)(L + SS_ST + (16 * n2 + li) * LP + (16 * w + 4 * lq) * 2) = o; }
#pragma unroll
        for (int r = 0; r < 4; ++r) *(LAS bf16*)(L + SS_OB + (16 * mt + 4 * lq + r) * 64 + (16 * nt + li) * 2) = (bf16)f2bf(oacc[r]);
        asm volatile("s_waitcnt vmcnt(1) lgkmcnt(0)" ::: "memory"); __builtin_amdgcn_s_barrier(); asm volatile("" ::: "memory");
    }
    ostore(131);
    asm volatile("s_waitcnt vmcnt(0) lgkmcnt(0)" ::: "memory"); __builtin_amdgcn_s_barrier(); asm volatile("" ::: "memory");
#undef SCHED_FENCE
#undef DMA16
#undef DMA4
}
__device__ __forceinline__ void phase_even_scan_d(Frame& F) {
    for (int vw = F.wg; vw < 256; vw += F.G) { const int cm = (vw & 7) + 8 * (vw >> 5), slice = (vw >> 3) & 3, chain = cm & 31; if ((cm >> 5) == 0) scan_chunks<0>(F, chain, slice); } }
__device__ __forceinline__ void phase_even_scan_h(Frame& F) {
    for (int vw = F.wg; vw < 256; vw += F.G) { const int cm = (vw & 7) + 8 * (vw >> 5), slice = (vw >> 3) & 3, chain = cm & 31; if ((cm >> 5) == 1) scan_chunks<1>(F, chain, slice); } }
__device__ __attribute__((noinline)) void phase_even_gate(Frame F, int l) {
    const int jl = l >> 1;
    const int gw = F.wg * NWAVES + F.wave, NGW = F.G * NWAVES;
    const int nrows = (l == DEPTH - 1) ? NLAT : ROWS;
    const bf16* O0 = WSP(bf16, WS_HN); const bf16* O1 = WSP(bf16, WS_ODIR) + (size_t)ROWS * 1024; const bf16* GG = WSP(bf16, WS_ODIR);
    for (int row = gw; row < nrows; row += NGW) {
#pragma unroll
        for (int mx = 0; mx < 2; ++mx) {
            const int ch = mx * 512 + F.lane * 8; float a[8], c[8], g[8];
            unpack8(*(const v4u*)(O0 + (size_t)row * 1024 + ch), a); unpack8(*(const v4u*)(O1 + (size_t)row * 1024 + ch), c);
            unpack8(*(const v4u*)(GG + (size_t)row * 1024 + ch), g);
            float ss = 0.f;
#pragma unroll
            for (int k = 0; k < 8; ++k) { a[k] += c[k]; ss += a[k] * a[k]; }
            ss = row16_sum(ss); const float rs = __builtin_amdgcn_rsqf(ss * (1.f / 128.f) + EPS);
            const float* nw = (mx ? INP(16) : INP(14)) + jl * 128 + (F.lane & 15) * 8;
#pragma unroll
            for (int k = 0; k < 8; ++k) a[k] = a[k] * rs * nw[k] * siluf_(g[k]);
            *(v4u*)(WSP(bf16, WS_HN) + (size_t)row * 1024 + ch) = pack8(a);
        }
    }
}

__device__ __forceinline__ void rope8(float (&x)[8], float (&y)[8], int pos, int i0) {
#pragma unroll
    for (int k = 0; k < 8; ++k) { const float inv = exp2f(-(float)(i0 + k) * (13.287712379549449f / 16.f)); const float rev = (float)pos * inv * 0.15915494309189535f;
        const float fr = rev - floorf(rev); const float sn = __builtin_amdgcn_sinf(fr), cs = __builtin_amdgcn_cosf(fr);
        const float a = x[k], b = y[k]; x[k] = a * cs - b * sn; y[k] = b * cs + a * sn; }
}
__device__ __attribute__((noinline)) void phase_odd_prep(Frame F, int l) {
    const int jl = l >> 1;
    bf16* P = WSP(bf16, WS_P);
    { const long total = (long)ROWS * 40; const long gt = (long)F.wg * NTHR + F.tid, GT = (long)F.G * NTHR;
      for (long it = gt; it < total; it += GT) { const int row = (int)(it / 40), r = (int)(it % 40), hd = r >> 2, half = (r >> 1) & 1, g8 = r & 1;
          bf16* p = P + (size_t)row * PO + (hd < 8 ? hd * 64 : 512 + (hd - 8) * 64) + half * 32 + g8 * 8;
          float x[8], y[8]; unpack8(*(const v4u*)p, x); unpack8(*(const v4u*)(p + 16), y);
          if (row < NLAT) { const int t = row & (SEQ - 1); rope8(x, y, half ? (t & 63) : (t >> 6), g8 * 8); }
          if (hd < 8) {
#pragma unroll
              for (int k = 0; k < 8; ++k) { x[k] *= 0.18033688011112042f; y[k] *= 0.18033688011112042f; } }
          *(v4u*)p = pack8(x); *(v4u*)(p + 16) = pack8(y); } }
}
__device__ __attribute__((noinline)) void phase_odd_prep_bc(Frame F, int l) {
    const int jl = l >> 1;
    bf16* P = WSP(bf16, WS_P);
    { LAS unsigned char* WTb = F.lds;
      LAS unsigned char* XCb = F.lds + 36864;
      LAS float* G = (LAS float*)(F.lds + 46080);
      LAS float* segA = (LAS float*)(F.lds + 112640); LAS float* segH = (LAS float*)(F.lds + 112640 + 4096);
      const float* wr = INP(22) + (size_t)jl * 2 * 8 * 4096; const float* wi = INP(24) + (size_t)jl * 2 * 8 * 4096;
      const float* cw = INP(20) + (size_t)jl * 4 * 512; const float* cb = INP(21) + jl * 512;
      int hprev = -1;
      LAS float* CWL = (LAS float*)(F.lds + 112640 + 8192);
      v4u pre[4];
      auto ldp = [&](int u2) { const int rown = (u2 >> 3) * 64 + (F.tid >> 3), hn = u2 & 7;
#pragma unroll
          for (int jj = 0; jj < 4; ++jj) { int r2 = rown + jj - 1; r2 = r2 < 0 ? 0 : (r2 > ROWS - 1 ? ROWS - 1 : r2); pre[jj] = *(const v4u*)(P + (size_t)r2 * PO + 768 + hn * 64 + (F.tid & 7) * 8); } };
      if (F.wg < (ROWS / 64) * 8) ldp(F.wg);
      float gpar[2][3] = {{0.f, 0.f, 0.f}, {0.f, 0.f, 0.f}};
      for (int u = F.wg; u < (ROWS / 64) * 8; u += F.G) {
          const int h = u & 7, r0 = (u >> 3) * 64;
          asm volatile("" : "+v"(F.tid)); F.lane = F.tid & 63;
          const int j = 16 * (F.wave & 3) + (F.lane & 15), tg = 4 * (F.wave >> 2) + (F.lane >> 4);
          __syncthreads();
          if (h != hprev) { for (int i2 = F.tid; i2 < 4 * 4096; i2 += NTHR) { const int g = i2 >> 12, z = g & 1, ii = (i2 >> 6) & 63, jj = i2 & 63;
                  *(LAS bf16*)(WTb + (g * 64 + jj) * 144 + ii * 2) = (bf16)f2bf(((g >> 1) ? wi : wr)[((size_t)z * 8 + h) * 4096 + ii * 64 + jj]); }
              if (F.tid < 320) CWL[F.tid] = F.tid < 256 ? cw[(F.tid >> 6) * 512 + h * 64 + (F.tid & 63)] : cb[h * 64 + (F.tid - 256)];
#pragma unroll
              for (int z = 0; z < 2; ++z) { const int c = h * 64 + 16 * (F.wave & 3) + (F.lane & 15); gpar[z][0] = INP(23)[(jl * 2 + z) * 512 + c]; gpar[z][1] = INP(25)[(jl * 2 + z) * 512 + c]; gpar[z][2] = log1pf(__expf(-INP(26)[(jl * 2 + z) * 512 + c])); }
              hprev = h; __syncthreads(); }
          { const int rr = F.tid >> 3, c8 = (F.tid & 7) * 8, row = r0 + rr, lo = seq_lo(row), hi = seq_hi(row); float a[8];
#pragma unroll
            for (int k = 0; k < 8; ++k) a[k] = CWL[256 + c8 + k];
#pragma unroll
            for (int jj = 0; jj < 4; ++jj) { const int r2 = row + jj - 1; const bool ok = r2 >= lo && r2 < hi;
                float x[8]; unpack8(pre[jj], x); const f32x4 w0 = *(const LAS f32x4*)(CWL + jj * 64 + c8), w1 = *(const LAS f32x4*)(CWL + jj * 64 + c8 + 4);
#pragma unroll
                for (int k = 0; k < 8; ++k) a[k] += (ok ? (k < 4 ? w0[k & 3] : w1[k & 3]) : 0.f) * x[k]; }
            *(LAS v4u*)(XCb + rr * 144 + c8 * 2) = pack8(a); }
          { const int un = u + F.G; ldp(un < (ROWS / 64) * 8 ? un : u); }
          __syncthreads();
          float acc[8][4];
          { const int w = F.wave, li = F.lane & 15, lq = F.lane >> 4, cg = w & 3, rh = w >> 2;
            bf16x8 aF[2][2];
#pragma unroll
            for (int mt = 0; mt < 2; ++mt)
#pragma unroll
                for (int s2 = 0; s2 < 2; ++s2) aF[mt][s2] = *(const LAS bf16x8*)(XCb + (32 * rh + 8 * (li >> 2) + 4 * mt + (li & 3)) * 144 + (32 * s2 + 8 * lq) * 2);
#pragma unroll
            for (int g = 0; g < 4; ++g) { const bf16x8 b0 = *(const LAS bf16x8*)(WTb + (g * 64 + 16 * cg + li) * 144 + (8 * lq) * 2), b1 = *(const LAS bf16x8*)(WTb + (g * 64 + 16 * cg + li) * 144 + (32 + 8 * lq) * 2);
#pragma unroll
                for (int mt = 0; mt < 2; ++mt) { f32x4 c4 = (f32x4){0.f, 0.f, 0.f, 0.f}; c4 = MFMA16(aF[mt][0], b0, c4); c4 = MFMA16(aF[mt][1], b1, c4);
#pragma unroll
                    for (int r = 0; r < 4; ++r) acc[4 * mt + r][g] = c4[r]; } } }
          const int c = h * 64 + j;
          float lat[2][8], ut[2][8];
#pragma unroll
          for (int z = 0; z < 2; ++z) { const float br = gpar[z][0], bi = gpar[z][1], sp = gpar[z][2];
#pragma unroll
              for (int t = 0; t < 8; ++t) { const float r = sigmoidf_(acc[t][z] + br), gi = sigmoidf_(acc[t][2 + z] + bi);
                  const float a = __expf(-8.f * sp * r); const float xc = bf1(*(const LAS bf16*)(XCb + (tg * 8 + t) * 144 + j * 2));
                  lat[z][t] = a; ut[z][t] = __builtin_amdgcn_sqrtf(fmaxf(1.f - a * a, 0.f)) * gi * xc; } }
          float hl[2][8], cd[2][8], sgA[2], sgH[2];
          { float hh = 0.f, cc = 1.f;
#pragma unroll
            for (int t = 0; t < 8; ++t) { const float a = lat[0][t]; hh = a * hh + ut[0][t]; cc *= a; hl[0][t] = hh; cd[0][t] = cc; }
            sgA[0] = cc; sgH[0] = hh; hh = 0.f; cc = 1.f;
#pragma unroll
            for (int t = 7; t >= 0; --t) { const float a = lat[1][t]; hh = a * hh + ut[1][t]; cc *= a; hl[1][t] = hh; cd[1][t] = cc; }
            sgA[1] = cc; sgH[1] = hh; }
#pragma unroll
          for (int z = 0; z < 2; ++z) { segA[(z * 8 + tg) * 64 + j] = sgA[z]; segH[(z * 8 + tg) * 64 + j] = sgH[z]; }
          __syncthreads();
          const int tile = r0 >> 6;
#pragma unroll
          for (int z = 0; z < 2; ++z) {
              float carry = 0.f, pre = 1.f;
              if (z == 0) { for (int sI = 0; sI < tg; ++sI) { const float a = segA[(sI) * 64 + j]; carry = a * carry + segH[(sI) * 64 + j]; pre *= a; } }
              else { for (int sI = 7; sI > tg; --sI) { const float a = segA[(8 + sI) * 64 + j]; carry = a * carry + segH[(8 + sI) * 64 + j]; pre *= a; } }
#pragma unroll
              for (int t = 0; t < 8; ++t) { const int row = r0 + tg * 8 + t;
                  WSP(bf16, WS_LA)[(size_t)row * 1024 + z * 512 + c] = (bf16)f2bf(hl[z][t] + cd[z][t] * carry); WSP(bf16, WS_U)[(size_t)row * 1024 + z * 512 + c] = (bf16)f2bf(cd[z][t] * pre); }
              if (tg == (z ? 0 : 7)) { WSP(float, WS_TA)[((size_t)tile * 2 + z) * 512 + c] = pre * sgA[z]; WSP(float, WS_TH)[((size_t)tile * 2 + z) * 512 + c] = sgA[z] * carry + sgH[z]; }
          }
      }
      __syncthreads(); }
}

__device__ __forceinline__ void rglru_scan(Frame& F, int sw) {
    const int b = sw >> 1, z = sw & 1, c = F.tid;
    const float* TA = WSP(float, WS_TA) + z * 512 + c; const float* TH = WSP(float, WS_TH) + z * 512 + c; float* CR = WSP(float, WS_CARRY) + z * 512 + c;
    float carry = 0.f;
    for (int k0 = 0; k0 < 132; k0 += 12) {
        float a[12], hh[12]; int tl[12];
#pragma unroll
        for (int k = 0; k < 12; ++k) { const int kk = k0 + k; const int tile = kk < 4 ? 512 + b * 4 + (z ? 3 - kk : kk) : b * 128 + (z ? 127 - (kk - 4) : (kk - 4)); tl[k] = tile; a[k] = TA[(size_t)tile * 1024]; hh[k] = TH[(size_t)tile * 1024]; }
#pragma unroll
        for (int k = 0; k < 12; ++k) { CR[(size_t)tl[k] * 1024] = carry; carry = a[k] * carry + hh[k]; }
    }
}
template <bool V> struct BoolC { static constexpr bool v = V; };
constexpr int ATT_UL = NB * (SEQ / 32), ATT_UC = NB * (CTXL / 32);
constexpr int AT_K = 0, AT_V = 9216, AT_BUF = 18432;
__device__ __forceinline__ void attn_unit(Frame& F, int l, int u) {
    const int jl = l >> 1; const int tid = F.tid, lane = F.lane, hh = F.wave, kvh = hh >> 2, qn = lane & 15, qd = lane >> 4;
    const bf16* P = WSP(bf16, WS_P);
    LAS unsigned char* L = F.lds;
    const bool isctx = u >= ATT_UL;
    int b, t0, qrow0;
    if (!isctx) { b = u >> 8; t0 = (u & 255) * 32; qrow0 = b * SEQ + t0; } else { const int v = u - ATT_UL; b = v >> 3; t0 = (v & 7) * 32; qrow0 = NLAT + b * CTXL + t0; }
    const float L2E = 1.4426950408889634f;
    bf16x8 qf[2][2];
#pragma unroll
    for (int qt = 0; qt < 2; ++qt)
#pragma unroll
        for (int ks = 0; ks < 2; ++ks) qf[qt][ks] = *(const bf16x8*)(P + (size_t)(qrow0 + 16 * qt + qn) * PO + hh * 64 + ks * 32 + qd * 8);
    const float sink = INP(19)[jl * 8 + hh] * L2E;
    float m[2] = {sink, sink}, lsum[2]; lsum[0] = (qd == 0) ? 1.f : 0.f; lsum[1] = lsum[0];
    f32x4 oacc[2][4];
#pragma unroll
    for (int qt = 0; qt < 2; ++qt)
#pragma unroll
        for (int dt = 0; dt < 4; ++dt) oacc[qt][dt] = (f32x4){0.f, 0.f, 0.f, 0.f};
    int klo[2], khi[2];
#pragma unroll
    for (int qt = 0; qt < 2; ++qt) { const int t = t0 + 16 * qt + qn; klo[qt] = t - 128 < 0 ? 0 : t - 128; khi[qt] = t + 128 > SEQ - 1 ? SEQ - 1 : t + 128; }
    const int ngl = isctx ? 0 : 9, ng = ngl + 8;
    const int skv = tid >> 8, skey = (tid >> 3) & 31, sc8 = tid & 7;
    v4u rk, rv;
    auto gload = [&](int g) {
        const bool lat = g < ngl; const int s0 = lat ? (t0 - 128 + g * 32) : (g - ngl) * 32;
        const int s = s0 + skey; const int scl = s < 0 ? 0 : (s > SEQ - 1 ? SEQ - 1 : s);
        const int kr = lat ? (b * SEQ + scl) : (NLAT + b * CTXL + s);
        const bf16* kp = P + (size_t)kr * PO + 512 + skv * 64 + sc8 * 8; rk = *(const v4u*)kp; rv = *(const v4u*)(kp + 128);
    };
    auto lstore = [&](int buf) { LAS unsigned char* d = L + buf * AT_BUF + (skv * 32 + skey) * 144 + sc8 * 16; *(LAS v4u*)(d + AT_K) = rk; *(LAS v4u*)(d + AT_V) = rv; };
    auto gcomp = [&](int g, int buf, auto maskc) {
        constexpr bool MASKED = decltype(maskc)::v;
        const bool lat = g < ngl; const int s0 = lat ? (t0 - 128 + g * 32) : (g - ngl) * 32;
        const LAS unsigned char* kb = L + buf * AT_BUF + AT_K + kvh * (32 * 144); const LAS unsigned char* vb = L + buf * AT_BUF + AT_V + kvh * (32 * 144);
        bf16x8 kf[2][2], vf[4];
#pragma unroll
        for (int T = 0; T < 2; ++T)
#pragma unroll
            for (int ks = 0; ks < 2; ++ks) kf[T][ks] = *(const LAS bf16x8*)(kb + (16 * T + qn) * 144 + (32 * ks + 8 * qd) * 2);
        { const int qp = qn >> 2, pp = qn & 3;
#pragma unroll
          for (int dt = 0; dt < 4; ++dt) { const LAS unsigned char* a = vb + (4 * qd + qp) * 144 + (16 * dt + 4 * pp) * 2;
              const s16x4 lo = __builtin_bit_cast(s16x4, __builtin_amdgcn_ds_read_tr16_b64_v4i16((LAS s16x4*)a));
              const s16x4 hi = __builtin_bit_cast(s16x4, __builtin_amdgcn_ds_read_tr16_b64_v4i16((LAS s16x4*)(a + 16 * 144)));
              vf[dt] = (bf16x8){lo[0], lo[1], lo[2], lo[3], hi[0], hi[1], hi[2], hi[3]}; } }
#pragma unroll
        for (int qt = 0; qt < 2; ++qt) {
            f32x4 sc[2];
#pragma unroll
            for (int T = 0; T < 2; ++T) { f32x4 a = (f32x4){0.f, 0.f, 0.f, 0.f}; a = MFMA16(kf[T][0], qf[qt][0], a); a = MFMA16(kf[T][1], qf[qt][1], a); sc[T] = a; }
            float mx = -3.0e38f;
#pragma unroll
            for (int T = 0; T < 2; ++T)
#pragma unroll
                for (int r = 0; r < 4; ++r) { if constexpr (MASKED) { const int s = s0 + 16 * T + 4 * qd + r; const bool ok = (s >= klo[qt]) & (s <= khi[qt]); sc[T][r] = ok ? sc[T][r] : -3.0e38f; }
                    mx = fmaxf(mx, sc[T][r]); }
            if (!__all(mx - m[qt] <= 8.f)) {
                mx = fmaxf(mx, __shfl_xor(mx, 16)); mx = fmaxf(mx, __shfl_xor(mx, 32));
                const float mn = fmaxf(m[qt], mx), alpha = __builtin_amdgcn_exp2f(m[qt] - mn); m[qt] = mn; lsum[qt] *= alpha;
#pragma unroll
                for (int dt = 0; dt < 4; ++dt) oacc[qt][dt] *= alpha;
            }
            const float mn = m[qt];
            float p[8]; float ps = 0.f;
#pragma unroll
            for (int T = 0; T < 2; ++T)
#pragma unroll
                for (int r = 0; r < 4; ++r) { const float e = __builtin_amdgcn_exp2f(sc[T][r] - mn); p[4 * T + r] = e; ps += e; }
            lsum[qt] += ps;
            const bf16x8 pf = __builtin_bit_cast(bf16x8, pack8(p));
#pragma unroll
            for (int dt = 0; dt < 4; ++dt) oacc[qt][dt] = MFMA16(vf[dt], pf, oacc[qt][dt]);
        }
    };
    __syncthreads();
    gload(0); lstore(0);
    __syncthreads();
    for (int g = 0; g < ng; ++g) {
        if (g + 1 < ng) gload(g + 1);
        { const int s0g = t0 - 128 + g * 32; const bool need = g < ngl && (g == 0 || g == ngl - 1 || s0g < 0 || s0g + 31 > SEQ - 1);
          if (need) gcomp(g, g & 1, BoolC<true>{}); else gcomp(g, g & 1, BoolC<false>{}); }
        if (g + 1 < ng) lstore((g + 1) & 1);
        __syncthreads();
    }
#pragma unroll
    for (int qt = 0; qt < 2; ++qt) {
        float ls = lsum[qt]; ls += __shfl_xor(ls, 16); ls += __shfl_xor(ls, 32);
        const float inv = 1.f / ls;
        bf16* op = WSP(bf16, WS_HN) + (size_t)(qrow0 + 16 * qt + qn) * 1024 + hh * 64 + 4 * qd;
#pragma unroll
        for (int dt = 0; dt < 4; ++dt) { v2u o; o.x = pk2(oacc[qt][dt][0] * inv, oacc[qt][dt][1] * inv); o.y = pk2(oacc[qt][dt][2] * inv, oacc[qt][dt][3] * inv); *(v2u*)(op + dt * 16) = o; }
    }
}
__device__ __forceinline__ void phase_odd_mix(Frame& F_, int l) {
    Frame F = F_; asm volatile("" : "+v"(F.tid)); F.lane = F.tid & 63;
    const int nunits = ATT_UL + ((l == DEPTH - 1) ? 0 : ATT_UC);
    if (F.G >= 16) {
        if (F.wg < 8) { rglru_scan(F, F.wg); return; }
        for (int u = F.wg - 8; u < nunits; u += F.G - 8) attn_unit(F, l, u);
    } else {
        for (int sw = F.wg; sw < 8; sw += F.G) rglru_scan(F, sw);
        for (int u = F.wg; u < nunits; u += F.G) attn_unit(F, l, u);
    }
}
__device__ __attribute__((noinline)) void phase_odd_gate(Frame F, int l) {
    const int gw = F.wg * NWAVES + F.wave, NGW = F.G * NWAVES;
    const int nrows = (l == DEPTH - 1) ? NLAT : ROWS;
    const bf16* HL = WSP(bf16, WS_LA); const bf16* DC = WSP(bf16, WS_U); const float* CR = WSP(float, WS_CARRY); const bf16* P = WSP(bf16, WS_P);
    for (int row = gw; row < nrows; row += NGW) {
        const int ch = F.lane * 8; const int tile = row >> 6; float a[8], g[8];
#pragma unroll
        for (int k = 0; k < 8; ++k) a[k] = 0.f;
#pragma unroll
        for (int z = 0; z < 2; ++z) { float hl[8], dc[8]; unpack8(*(const v4u*)(HL + (size_t)row * 1024 + z * 512 + ch), hl); unpack8(*(const v4u*)(DC + (size_t)row * 1024 + z * 512 + ch), dc);
            const f32x4 c0 = *(const f32x4*)(CR + ((size_t)tile * 2 + z) * 512 + ch), c1 = *(const f32x4*)(CR + ((size_t)tile * 2 + z) * 512 + ch + 4);
#pragma unroll
            for (int k = 0; k < 8; ++k) a[k] += hl[k] + dc[k] * (k < 4 ? c0[k] : c1[k - 4]); }
        unpack8(*(const v4u*)(P + (size_t)row * PO + 1280 + ch), g);
#pragma unroll
        for (int k = 0; k < 8; ++k) { const float x = g[k]; const float tt = 0.7978845608028654f * (x + 0.044715f * x * x * x); const float th = 1.f - 2.f * __builtin_amdgcn_rcpf(1.f + __expf(2.f * tt));
            a[k] = a[k] * 0.5f * x * (1.f + th); }
        *(v4u*)(WSP(bf16, WS_HN) + (size_t)row * 1024 + 512 + ch) = pack8(a);
    }
}

__device__ __forceinline__ void phase_topk(Frame& F_, int l) {
    Frame F = F_; asm volatile("" : "+v"(F.tid)); F.lane = F.tid & 63;
    LAS unsigned* keys = (LAS unsigned*)F.lds;
    LAS unsigned* hist = (LAS unsigned*)(F.lds + 32768);
    LAS unsigned* sel = (LAS unsigned*)(F.lds + 32768 + 1024);
    LAS unsigned* wsum = (LAS unsigned*)(F.lds + 32768 + 1024 + 64);
    const int nprob = (l == DEPTH - 1) ? 64 : 128;
    const float* AFF = WSP(float, WS_AFF);
    for (int p = F.wg; p < nprob; p += F.G) {
        const bool isctx = p >= 64; const int b = (p & 63) >> 4, e = p & 15;
        const int n = isctx ? CTXL : SEQ, cap = isctx ? CAP_C : CAP_L, rowbase = isctx ? NLAT + b * CTXL : b * SEQ;
        const int slotbase = isctx ? NSLOT_L + e * 256 + b * CAP_C : (e * 4 + b) * CAP_L;
        __syncthreads();
        { const float* src = isctx ? AFF + (size_t)NB * 16 * SEQ + (size_t)(b * 16 + e) * CTXL : AFF + (size_t)(b * 16 + e) * SEQ;
          for (int i = F.tid; i < n; i += NTHR) keys[i] = __builtin_bit_cast(unsigned, src[i]); }
        unsigned prefix = 0u, need = (unsigned)cap;
        for (int pass = 3; pass >= 0; --pass) {
            const int shift = pass * 8;
            if (F.tid < 256) hist[F.tid] = 0u;
            __syncthreads();
            for (int i = F.tid; i < n; i += NTHR) { const unsigned k = keys[i]; const bool in = (pass == 3) || ((k >> (shift + 8)) == (prefix >> (shift + 8))); if (in) atomicAdd((unsigned*)&hist[(k >> shift) & 255u], 1u); }
            __syncthreads();
            if (F.wave == 0) {
                unsigned c[4], s = 0u;
#pragma unroll
                for (int j = 0; j < 4; ++j) { c[j] = hist[255 - (4 * F.lane + j)]; s += c[j]; }
                unsigned inc = s;
#pragma unroll
                for (int o = 1; o < 64; o <<= 1) { const unsigned t = __shfl_up(inc, o); if (F.lane >= o) inc += t; }
                const unsigned long long m = __ballot(inc >= need);
                const int Ls = __builtin_ctzll(m);
                if (F.lane == Ls) { unsigned cum = inc - s, d = 0u, nn = need; bool done = false;
#pragma unroll
                    for (int j = 0; j < 4; ++j) { if (!done && cum + c[j] >= need) { d = 255u - (unsigned)(4 * F.lane + j); nn = need - cum; done = true; } cum += c[j]; }
                    sel[0] = d; sel[1] = nn; } }
            __syncthreads();
            prefix |= sel[0] << shift; need = sel[1];
        }
        const unsigned T = prefix;
        const int ept = isctx ? 1 : 16; const int i0 = F.tid * ept;
        unsigned gt = 0u, eq = 0u;
        if (i0 < n) for (int i = 0; i < ept; ++i) { const unsigned k = keys[i0 + i]; gt += (k > T); eq += (k == T); }
        unsigned pk = gt | (eq << 16), incl = pk;
#pragma unroll
        for (int o = 1; o < 64; o <<= 1) { const unsigned t = __shfl_up(incl, o); if (F.lane >= o) incl += t; }
        if (F.lane == 63) wsum[F.wave] = incl;
        __syncthreads();
        unsigned wpre = 0u;
        for (int w = 0; w < F.wave; ++w) wpre += wsum[w];
        unsigned excl = wpre + incl - pk; unsigned gtb = excl & 0xffffu, eqb = excl >> 16;
        if (i0 < n) for (int i = 0; i < ept; ++i) { const unsigned k = keys[i0 + i]; int c = -1;
            if (k > T) { c = (int)(gtb + (eqb < need ? eqb : need)); ++gtb; }
            else if (k == T) { if (eqb < need) c = (int)(gtb + eqb); ++eqb; }
            const int row = rowbase + i0 + i;
            WSP(int, WS_INV)[(size_t)row * 16 + e] = c;
            if (c >= 0) { WSP(int, WS_IDX)[slotbase + c] = row; WSP(float, WS_GATES)[slotbase + c] = __builtin_bit_cast(float, k); } }
    }
    __syncthreads();
}
__device__ __attribute__((noinline)) void phase_gather(Frame F, int l) {
    const int gw = F.wg * NWAVES + F.wave, NGW = F.G * NWAVES;
    const int nslot = (l == DEPTH - 1) ? NSLOT_L : NSLOT_ALL;
    const int* IDX = WSP(int, WS_IDX); const bf16* HN = WSP(bf16, WS_HN); bf16* XS = WSP(bf16, WS_XS);
    for (int s = gw; s < nslot; s += NGW) {
        if (s >= NSLOT_L && ((s - NSLOT_L) & 255) >= 128) continue;
        const int row = IDX[s];
        const v4u a = *(const v4u*)(HN + (size_t)row * 1024 + F.lane * 8), c = *(const v4u*)(HN + (size_t)row * 1024 + 512 + F.lane * 8);
        *(v4u*)(XS + (size_t)s * 1024 + F.lane * 8) = a; *(v4u*)(XS + (size_t)s * 1024 + 512 + F.lane * 8) = c;
    }
}

constexpr int PPL = 12, NPH = 2 + DEPTH * PPL;
struct Args { const float* in[31]; float* out; unsigned char* ws; int ph_lo, ph_hi; };
__global__ void __launch_bounds__(NTHR, 2) mk_fwd(Args args) {
    extern __shared__ __attribute__((aligned(16))) unsigned char lds[];
    Frame F;
    F.lds = (LAS unsigned char*)lds;
    F.tid = threadIdx.x; F.lane = F.tid & 63; F.wave = __builtin_amdgcn_readfirstlane(F.tid >> 6);
    F.G = gridDim.x; F.wg = blockIdx.x;
    F.out = (GAS float*)args.out; F.ws = (GAS unsigned char*)args.ws;
    const int lo = args.ph_lo, hi = args.ph_hi;
    volatile LAS unsigned* MISC = (volatile LAS unsigned*)(F.lds + MISC_OFF);
    if (F.tid < 32) MISC[F.tid] = 0u;
    if (F.tid == 0) {
#pragma unroll
        for (int i = 0; i < 31; ++i) ((const GAS float* LAS*)(F.lds + PTR_OFF))[i] = (const GAS float*)args.in[i];
    }
    __syncthreads();
    unsigned* barw = (unsigned*)(F.ws + WS_CTL) + CW_BAR;
    XcdBarrier bar; bar.bar = barw; bar.x = 0; bar.st = nullptr;
    if (hi - lo > 1) bar = xcd_barrier_post(barw, MISC + 8);
#ifndef PH_SUB
#define PH_SUB -1
#endif
#ifndef PH_ONLY
#define PH_ONLY -1
#endif
#define KIND(k) ((k) == 0 ? 0 : ((k) == NPH - 1 ? 13 : 1 + ((k) - 1) % PPL))
#define IN(k) ((PH_ONLY < 0 || PH_ONLY == KIND(k)) && lo <= (k) && (k) < hi)
#define NREP(kind, sub) ((REPK == (kind) && (kind) != 2 && (kind) != 7 && (kind) != 11 && (kind) != 12 && (REPS < 0 || REPS == (sub))) ? 2 : 1)
#define SEAM(k) do { if (IN(k) && IN((k) + 1)) xcd_barrier(bar); } while (0)
    if (IN(0)) { phase_mod(F); }
    SEAM(0);
    for (int l = 0; l < DEPTH; ++l) {
        const int pb = 1 + l * PPL; const bool even = !(l & 1), last = (l == DEPTH - 1);
        if (IN(pb + 0)) { if (l == 0) phase_weights(F, 0, 0, witems_w2(0) - 8192, 0); if (l == 0) phase_rp1_t<true>(F, l); else phase_rp1_t<false>(F, l); }
        SEAM(pb + 0);
        if (IN(pb + 1)) { const int N = even ? PE : PO;
            pg8::Gemm g{WSP(pg8::bf16_t, WS_HN), WSP(pg8::bf16_t, WS_WIN), ROWS, N, DM, 0}; pg8::StaticOrder S; S.init(ROWS, N, F.G, F.wg);
            if (even) { pg8::EpiEvenIn E{WSP(pg8::bf16_t, WS_P), WSP(pg8::bf16_t, WS_ODIR), WSP(pg8::bf16_t, WS_HQ), WSP(pg8::bf16_t, WS_HK), WSP(pg8::bf16_t, WS_IB), WSP(float, WS_GB), WSP(float, WS_OMT) + (l >> 1) * 1024, INP(12) + (l >> 1) * 8, INP(13) + (l >> 1) * 8};
                pg8::gemm_phase<pg8::EpiEvenIn, pg8::StaticOrder, true, true>(F.lds, g, S, E); }
            else { pg8::EpiStoreBf16 E{WSP(pg8::bf16_t, WS_P), N, nullptr};
                pg8::gemm_phase<pg8::EpiStoreBf16, pg8::StaticOrder, true, true>(F.lds, g, S, E); }
            if (last && l > 0) phase_weights(F, l, witems_w2(l), witems_w2(l) + 4096, S.nwg % F.G);
            if (l == 0) phase_weights(F, 0, witems_w2(0) - 8192, witems_w2(0) - 8192 + 944, S.nwg % F.G); }
#if REPK == 2
        if (IN(pb + 1)) { const int N = even ? PE : PO;
            pg8::Gemm g{WSP(pg8::bf16_t, WS_HN), WSP(pg8::bf16_t, WS_WIN), ROWS, N, DM, 0}; pg8::StaticOrder S; S.init(ROWS, N, F.G, F.wg);
            if (even) { pg8::EpiEvenIn E{WSP(pg8::bf16_t, WS_P), WSP(pg8::bf16_t, WS_ODIR), WSP(pg8::bf16_t, WS_HQ), WSP(pg8::bf16_t, WS_HK), WSP(pg8::bf16_t, WS_IB), WSP(float, WS_GB), WSP(float, WS_OMT) + (l >> 1) * 1024, INP(12) + (l >> 1) * 8, INP(13) + (l >> 1) * 8};
                pg8::gemm_phase<pg8::EpiEvenIn, pg8::StaticOrder, true, true>(F.lds, g, S, E); }
            else { pg8::EpiStoreBf16 E{WSP(pg8::bf16_t, WS_P), N, nullptr};
                pg8::gemm_phase<pg8::EpiStoreBf16, pg8::StaticOrder, true, true>(F.lds, g, S, E); } }
#endif
        SEAM(pb + 1);
        if (IN(pb + 2)) { if (even) { if (PH_SUB != 1) for (int rp = 0; rp < NREP(3, 0); ++rp) { phase_even_prep(F, l); } } else { if (PH_SUB != 0) { phase_odd_prep(F, l); for (int rp = 0; rp < NREP(3, 1); ++rp) phase_odd_prep_bc(F, l); } } }
        SEAM(pb + 2);
        if (IN(pb + 3)) { if (even) { for (int rp = 0; rp < NREP(4, 0); ++rp) phase_even_chunk_d(F); for (int rp = 0; rp < NREP(4, 1); ++rp) phase_even_chunk_h(F); } }
        if (even) SEAM(pb + 3);
        if (IN(pb + 4)) { if (even) { if (PH_SUB != 1) for (int rp = 0; rp < NREP(5, 0); ++rp) { for (int r2 = 0; r2 < NREP(5, 2); ++r2) phase_even_scan_d(F); for (int r3 = 0; r3 < NREP(5, 3); ++r3) phase_even_scan_h(F); } } else { if (PH_SUB != 0) for (int rp = 0; rp < NREP(5, 1); ++rp) phase_odd_mix(F, l); } }
        SEAM(pb + 4);
        if (IN(pb + 5)) for (int rp = 0; rp < NREP(6, -1); ++rp) { if (even) phase_even_gate(F, l); else phase_odd_gate(F, l); }
        SEAM(pb + 5);
        if (IN(pb + 6)) { const int M = last ? NLAT : ROWS;
            pg8::Gemm g{WSP(pg8::bf16_t, WS_HN), WSP(pg8::bf16_t, WS_WOUT), M, DM, DM, 0}; pg8::StaticOrder S; S.init(M, DM, F.G, F.wg);
            pg8::EpiResid E{l == 0 ? INP(0) : nullptr, INP(2), WSP(pg8::bf16_t, WS_X), WSP(float, WS_MOD) + (size_t)l * 5 * 6144 + 2048};
            pg8::gemm_phase<pg8::EpiResid, pg8::StaticOrder, true, true>(F.lds, g, S, E);
            if (l > 0 && !last) phase_weights(F, l, witems_w2(l) - 3072, witems_w2(l), S.nwg % F.G);
            if (l == 0) phase_weights(F, 0, witems_w2(0) - 8192 + 944, witems_w2(0), S.nwg % F.G); }
        SEAM(pb + 6);
        if (IN(pb + 7)) for (int rp = 0; rp < NREP(8, -1); ++rp) { phase_rp2(F, l); }
        SEAM(pb + 7);
        if (IN(pb + 8)) for (int rp = 0; rp < NREP(9, -1); ++rp) { phase_topk(F, l); }
        SEAM(pb + 8);
        if (IN(pb + 9)) for (int rp = 0; rp < NREP(10, -1); ++rp) {   }
        if (IN(pb + 10)) for (int rp = 0; rp < NREP(11, -1); ++rp) { const int M = last ? NSLOT_L : NSLOT_ALL;
            pg8::Gemm g{WSP(pg8::bf16_t, WS_HN), WSP(pg8::bf16_t, WS_W13), M, 2048, DM, (size_t)2048 * 1024 * 2, WSP(int, WS_IDX), ROWS}; pg8::StaticOrder S; S.init(M, 2048, F.G, F.wg);
            pg8::EpiSwiGLU E{WSP(pg8::bf16_t, WS_HID)};
            pg8::gemm_phase<pg8::EpiSwiGLU, pg8::StaticOrder, true, true, true>(F.lds, g, S, E);
            if (!last) phase_weights(F, l, witems_w2(l), witems_w2(l) + 4096, S.nwg % F.G); }
#if REPK == 11
        if (IN(pb + 10)) { const int M = last ? NSLOT_L : NSLOT_ALL;
            pg8::Gemm g{WSP(pg8::bf16_t, WS_HN), WSP(pg8::bf16_t, WS_W13), M, 2048, DM, (size_t)2048 * 1024 * 2, WSP(int, WS_IDX), ROWS}; pg8::StaticOrder S; S.init(M, 2048, F.G, F.wg);
            pg8::EpiSwiGLU E{WSP(pg8::bf16_t, WS_HID)};
            pg8::gemm_phase<pg8::EpiSwiGLU, pg8::StaticOrder, true, true, true>(F.lds, g, S, E); }
#endif
        SEAM(pb + 10);
        if (IN(pb + 11)) for (int rp = 0; rp < NREP(12, -1); ++rp) { const int M = last ? NSLOT_L : NSLOT_ALL;
#if REPK == 13
            pg8::Gemm g{WSP(pg8::bf16_t, WS_HID), WSP(pg8::bf16_t, WS_W2), M, DM, FF, (size_t)1024 * 1024 * 2, nullptr, 0, 1}; pg8::StaticOrder S; S.init(M, DM, F.G, F.wg);
            pg8::EpiStoreBf16 E{WSP(pg8::bf16_t, WS_Y2), 1024, nullptr, 0.5f};
#elif REPK == 14
            pg8::Gemm g{WSP(pg8::bf16_t, WS_HID), WSP(pg8::bf16_t, WS_W2), M, DM, FF, (size_t)1024 * 1024 * 2, nullptr, 0, 1}; pg8::StaticOrder S; S.init(M, DM, F.G, F.wg);
            pg8::EpiStoreBf16 E{WSP(pg8::bf16_t, WS_Y2), 1024, nullptr};
#else
            pg8::Gemm g{WSP(pg8::bf16_t, WS_HID), WSP(pg8::bf16_t, WS_W2), M, DM, FF, (size_t)1024 * 1024 * 2}; pg8::StaticOrder S; S.init(M, DM, F.G, F.wg);
            pg8::EpiStoreBf16 E{WSP(pg8::bf16_t, WS_Y2), 1024, nullptr};
#endif
            pg8::gemm_phase<pg8::EpiStoreBf16, pg8::StaticOrder, true, true>(F.lds, g, S, E);
            if (!last) phase_weights(F, l + 1, 0, witems_w2(l + 1) - (l + 1 < DEPTH - 1 ? 3072 : 0), S.nwg % F.G); }
#if REPK == 12
        if (IN(pb + 11)) { const int M = last ? NSLOT_L : NSLOT_ALL;
            pg8::Gemm g{WSP(pg8::bf16_t, WS_HID), WSP(pg8::bf16_t, WS_W2), M, DM, FF, (size_t)1024 * 1024 * 2}; pg8::StaticOrder S; S.init(M, DM, F.G, F.wg);
            pg8::EpiStoreBf16 E{WSP(pg8::bf16_t, WS_Y2), 1024, nullptr};
            pg8::gemm_phase<pg8::EpiStoreBf16, pg8::StaticOrder, true, true>(F.lds, g, S, E); }
#endif
        SEAM(pb + 11);
    }
    if (IN(NPH - 1)) phase_final(F);
#undef IN
#undef SEAM
}

extern "C" void kernel_launch(void* const* d_in, const int* in_sizes, int n_in, void* d_out, int out_size, void* d_ws, size_t ws_size, hipStream_t stream) {
    static int grid = 0;
    if (grid == 0) {
        if (n_in != 31 || in_sizes[0] != NLAT * DM || out_size != NLAT * DM || ws_size < WS_END) { fprintf(stderr, "kernel_launch: unexpected shapes / workspace (n_in %d, ws %zu); nothing launched\n", n_in, ws_size); grid = -1; return; }
        int dev = 0, cus = 0, per_cu = 0;
        if (hipGetDevice(&dev) != hipSuccess || hipDeviceGetAttribute(&cus, hipDeviceAttributeMultiprocessorCount, dev) != hipSuccess) { grid = -1; return; }
        if (hipFuncSetAttribute((const void*)mk_fwd, hipFuncAttributeMaxDynamicSharedMemorySize, LDS_BYTES) != hipSuccess) { fprintf(stderr, "kernel_launch: hipFuncSetAttribute failed\n"); grid = -1; return; }
        if (hipOccupancyMaxActiveBlocksPerMultiprocessor(&per_cu, (const void*)mk_fwd, NTHR, LDS_BYTES) != hipSuccess || per_cu < 1) { fprintf(stderr, "kernel_launch: occupancy query says %d\n", per_cu); }
        (void)hipGetLastError();
        grid = cus;
    }
    if (grid < 0) return;
    (void)hipMemsetAsync((char*)d_ws + WS_CTL, 0, CTL_ZERO_BYTES, stream);
    Args a{};
    for (int i = 0; i < 31; ++i) a.in[i] = (const float*)d_in[i];
    a.out = (float*)d_out; a.ws = (unsigned char*)d_ws;
#if MK_ONE_LAUNCH
    a.ph_lo = 0; a.ph_hi = NPH;
    hipLaunchKernelGGL(mk_fwd, dim3(grid), dim3(NTHR), LDS_BYTES, stream, a);
#else
    for (int k = 0; k < NPH; ++k) { a.ph_lo = k; a.ph_hi = k + 1; hipLaunchKernelGGL(mk_fwd, dim3(grid), dim3(NTHR), LDS_BYTES, stream, a); }
#endif
}
```
